# Optimizing an MI355X kernel written in HIP

```python
import jax, jax.numpy as jnp
from jax import lax
import numpy as np

D_MODEL = 1024
BATCH = 2
SEQ = 8192
DEPTH = 2

CONV_CH = D_MODEL // 2
CONV_K = 3
SGU_WIDTH = D_MODEL // 2
SGU_GROUPS = 4
SGU_GROUP_CH = SGU_WIDTH // SGU_GROUPS
CHUNK = 128
ATT_HEADS = 8
HEAD_DIM = 64
ATT_WIDTH = ATT_HEADS * HEAD_DIM
Q_BLOCK = 128
N_BRANCH = 3
D_FF = ((8 * D_MODEL + 3 * 256 - 1) // (3 * 256)) * 256
IN_COLS = 3 * CONV_CH + 2 * SGU_WIDTH + 3 * ATT_WIDTH + N_BRANCH * D_MODEL
EPS = 1e-6

kernel_name = "hybrid_gated_conv_sgu_stickbreaking"


def _rmsnorm(x, g):
    xf = x.astype(jnp.float32)
    y = xf * lax.rsqrt(jnp.mean(xf * xf, axis=-1, keepdims=True) + EPS)
    return (y * g.astype(jnp.float32)).astype(x.dtype)


def _layernorm(x, g, b):
    xf = x.astype(jnp.float32)
    mu = jnp.mean(xf, axis=-1, keepdims=True)
    xc = xf - mu
    y = xc * lax.rsqrt(jnp.mean(xc * xc, axis=-1, keepdims=True) + EPS)
    return (y * g.astype(jnp.float32) + b.astype(jnp.float32)).astype(x.dtype)


def _split_cols(p):
    widths = (CONV_CH, CONV_CH, CONV_CH, SGU_WIDTH, SGU_WIDTH,
              ATT_WIDTH, ATT_WIDTH, ATT_WIDTH, N_BRANCH * D_MODEL)
    out, off = [], 0
    for w in widths:
        out.append(p[..., off:off + w])
        off += w
    return out


def _short_conv(bg, cg, xa, w, b):
    u = cg * xa
    S = u.shape[1]
    up = jnp.pad(u, ((0, 0), (CONV_K - 1, 0), (0, 0)))
    y = b
    for k in range(CONV_K):
        y = y + w[k] * up[:, k:k + S]
    return bg * y


def _sgu(u, v, ln_g, ln_b, w_s, b_s):
    u = jax.nn.gelu(u, approximate=False)
    v = _layernorm(jax.nn.gelu(v, approximate=False), ln_g, ln_b)
    B, S, _ = v.shape
    vc = v.reshape(B, S // CHUNK, CHUNK, SGU_GROUPS, SGU_GROUP_CH)
    causal = jnp.tril(jnp.ones((CHUNK, CHUNK), dtype=bool))
    w = jnp.where(causal[None], w_s, 0.0).astype(v.dtype)
    mixed = jnp.einsum('gts,bnsgc->bntgc', w, vc) + b_s.T[None, None, :, :, None]
    return u * mixed.reshape(B, S, SGU_WIDTH)


def _stick_breaking(q, k, v):
    B, H, S, d = q.shape
    nb = S // Q_BLOCK
    scale = 1.0 / float(np.sqrt(d))
    qb = q.reshape(B, H, nb, Q_BLOCK, d).transpose(2, 0, 1, 3, 4)
    key_pos = jnp.arange(S)

    def block(args):
        qi, i = args
        z = jnp.einsum('bhqd,bhkd->bhqk', qi, k).astype(jnp.float32) * scale
        qpos = i * Q_BLOCK + jnp.arange(Q_BLOCK)
        mask = key_pos[None, :] < qpos[:, None]
        log_beta = jax.nn.log_sigmoid(z)
        log_1m = jnp.where(mask, jax.nn.log_sigmoid(-z), 0.0)
        after = lax.cumsum(log_1m, axis=3, reverse=True) - log_1m
        a = jnp.where(mask, jnp.exp(log_beta + after), 0.0)
        return jnp.einsum('bhqk,bhkd->bhqd', a.astype(v.dtype), v)

    out = lax.map(block, (qb, jnp.arange(nb)))
    return out.transpose(1, 2, 0, 3, 4).reshape(B, H, S, d)


def setup_inputs(seed: int = 0) -> dict:
    key = jax.random.key(seed)
    ks = jax.random.split(key, 17)
    L, D = DEPTH, D_MODEL
    nrm = lambda k, shape, s: jax.random.normal(k, shape, jnp.float32) * s
    return {
        "x": jax.random.normal(ks[0], (BATCH, SEQ, D), jnp.float32),
        "mix_norm_g": 1.0 + nrm(ks[1], (L, D), 0.02),
        "w_in": nrm(ks[2], (L, D, IN_COLS), D ** -0.5),
        "b_gate": nrm(ks[3], (L, N_BRANCH * D), 0.02),
        "conv_w": nrm(ks[4], (L, CONV_K, CONV_CH), CONV_K ** -0.5),
        "conv_b": nrm(ks[5], (L, CONV_CH), 0.02),
        "sgu_ln_g": 1.0 + nrm(ks[6], (L, SGU_WIDTH), 0.02),
        "sgu_ln_b": nrm(ks[7], (L, SGU_WIDTH), 0.02),
        "sgu_w": nrm(ks[8], (L, SGU_GROUPS, CHUNK, CHUNK), CHUNK ** -0.5),
        "sgu_b": nrm(ks[9], (L, SGU_GROUPS, CHUNK), 0.02),
        "q_norm_g": 1.0 + nrm(ks[10], (L, HEAD_DIM), 0.02),
        "k_norm_g": 1.0 + nrm(ks[11], (L, HEAD_DIM), 0.02),
        "w_branch_out": nrm(ks[12], (L, N_BRANCH, CONV_CH, D), CONV_CH ** -0.5),
        "w_o": nrm(ks[13], (L, D, D), D ** -0.5),
        "ffn_norm_g": 1.0 + nrm(ks[14], (L, D), 0.02),
        "w_gate_up": nrm(ks[15], (L, D, 2 * D_FF), D ** -0.5),
        "w_down": nrm(ks[16], (L, D_FF, D), D_FF ** -0.5),
    }


def reference(x, mix_norm_g, w_in, b_gate, conv_w, conv_b, sgu_ln_g, sgu_ln_b, sgu_w, sgu_b,
              q_norm_g, k_norm_g, w_branch_out, w_o, ffn_norm_g, w_gate_up, w_down):
    B, S, D = x.shape
    for l in range(DEPTH):
        h = _rmsnorm(x, mix_norm_g[l])
        a_b, a_c, a_x, s_u, s_v, q, k, v, gates = _split_cols(h @ w_in[l])

        ya = _short_conv(a_b, a_c, a_x, conv_w[l], conv_b[l])
        yb = _sgu(s_u, s_v, sgu_ln_g[l], sgu_ln_b[l], sgu_w[l], sgu_b[l])

        qh = _rmsnorm(q.reshape(B, S, ATT_HEADS, HEAD_DIM), q_norm_g[l]).transpose(0, 2, 1, 3)
        kh = _rmsnorm(k.reshape(B, S, ATT_HEADS, HEAD_DIM), k_norm_g[l]).transpose(0, 2, 1, 3)
        vh = v.reshape(B, S, ATT_HEADS, HEAD_DIM).transpose(0, 2, 1, 3)
        yc = _stick_breaking(qh, kh, vh).transpose(0, 2, 1, 3).reshape(B, S, ATT_WIDTH)

        ys = jnp.stack([ya, yb, yc], axis=2)
        yd = jnp.einsum('bsnc,ncd->bsnd', ys, w_branch_out[l])
        g = jax.nn.sigmoid(gates + b_gate[l]).reshape(B, S, N_BRANCH, D)
        merged = jnp.sum(g * yd, axis=2)
        x = x + merged @ w_o[l]

        h2 = _rmsnorm(x, ffn_norm_g[l])
        gu = h2 @ w_gate_up[l]
        x = x + (jax.nn.silu(gu[..., :D_FF]) * gu[..., D_FF:]) @ w_down[l]
    return x
```

```cpp
#include <hip/hip_runtime.h>
#include <hip/hip_cooperative_groups.h>
#include <cstdio>
#include <cstdint>
#include <cmath>
namespace cg = cooperative_groups;

#define LAS __attribute__((address_space(3)))
#define DI __device__ __forceinline__
typedef unsigned short bf16_t;
typedef short bf16x8 __attribute__((ext_vector_type(8)));
typedef float f32x4 __attribute__((ext_vector_type(4)));
typedef float f32x2 __attribute__((ext_vector_type(2)));
typedef float f32x16 __attribute__((ext_vector_type(16)));
typedef unsigned u32x4 __attribute__((ext_vector_type(4)));
typedef unsigned u32x2 __attribute__((ext_vector_type(2)));
typedef short s16x4 __attribute__((ext_vector_type(4)));

constexpr int T_ = 16384, D_ = 1024, SEQ_ = 8192, NMAIN = 4096, NIN = 7168, DFF = 2816, NGU = 5632;
constexpr int PMP = 4096 + 64;
constexpr int COL_GS = 512, COL_MG = 3072;
constexpr float EPS = 1e-6f;
constexpr float C2 = 0.125f * 1.4426950408889634f;
constexpr float THR2 = -150.0f;

constexpr size_t MiB = 1u << 20;
constexpr size_t WS_WL = 36 * MiB;
constexpr size_t W_IN = 0, W_BO = 14 * MiB, W_O = 17 * MiB, W_GU = 19 * MiB, W_DN = 30 * MiB, W_SG = 35 * MiB + 512 * 1024;
constexpr size_t WS_PART = 72 * MiB, WS_XB = 73 * MiB, WS_BIG = 105 * MiB, WS_END = 236 * MiB, WS_BAR = 236 * MiB, WS_RSV = 236 * MiB + 64 * 1024, WS_DMY = 237 * MiB, WS_XCC = 236 * MiB + 192 * 1024;

constexpr int LDS_BYTES = 135168;

typedef __bf16 bf16x2_t __attribute__((ext_vector_type(2)));
DI unsigned cvt_pk_bf16(float lo, float hi) { f32x2 v = {lo, hi}; bf16x2_t b = __builtin_convertvector(v, bf16x2_t); return __builtin_bit_cast(unsigned, b); }
DI float bf_lo(unsigned w) { return __uint_as_float(w << 16); }
DI float bf_hi(unsigned w) { return __uint_as_float(w & 0xffff0000u); }
DI float bf2f(bf16_t v) { return __uint_as_float(((unsigned)v) << 16); }
DI bf16_t f2bf(float f) { return (bf16_t)(cvt_pk_bf16(f, 0.f) & 0xffffu); }
DI void unpack8(const u32x4 w, float* f) { f[0] = bf_lo(w.x); f[1] = bf_hi(w.x); f[2] = bf_lo(w.y); f[3] = bf_hi(w.y); f[4] = bf_lo(w.z); f[5] = bf_hi(w.z); f[6] = bf_lo(w.w); f[7] = bf_hi(w.w); }
DI u32x4 pack8(const float* f) { u32x4 w; w.x = cvt_pk_bf16(f[0], f[1]); w.y = cvt_pk_bf16(f[2], f[3]); w.z = cvt_pk_bf16(f[4], f[5]); w.w = cvt_pk_bf16(f[6], f[7]); return w; }
DI float wave_sum(float v) {
#pragma unroll
    for (int o = 1; o < 64; o <<= 1) v += __shfl_xor(v, o);
    return v;
}
DI float sigmoidf_(float x) { return __builtin_amdgcn_rcpf(1.0f + __builtin_amdgcn_exp2f(-1.4426950408889634f * x)); }
DI f32x2 gelu_pk(f32x2 v) {
    const f32x2 av = __builtin_elementwise_abs(v), d = av * 0.2316418882f + 1.0f;
    f32x2 t; t.x = __builtin_amdgcn_rcpf(d.x); t.y = __builtin_amdgcn_rcpf(d.y);
    f32x2 q = t * 0.5307027145f + (-0.7265760135f); q = q * t + 0.7107068705f; q = q * t + (-0.142248368f); q = q * t + 0.127414796f; q = q * t;
    const f32x2 s = (v * v) * (-0.72134752044f);
    f32x2 e; e.x = __builtin_amdgcn_exp2f(s.x); e.y = __builtin_amdgcn_exp2f(s.y);
    const f32x2 m = v * (q * e), r = v - m;
    f32x2 o; o.x = v.x < 0.f ? m.x : r.x; o.y = v.y < 0.f ? m.y : r.y; return o;
}
DI f32x4 gelu4(f32x4 v) { f32x2 a = gelu_pk((f32x2){v[0], v[1]}), b = gelu_pk((f32x2){v[2], v[3]}); return (f32x4){a.x, a.y, b.x, b.y}; }

namespace pg8 {
constexpr int BM = 256, BK = 64, HALF = 128, HTB = HALF * BK * 2, STAGE_BYTES = 8 * HTB, NXCD = 8, WGM = 8;
DI int lds_byte(int r, int c) { const int st = (r >> 4) * 2 + (c >> 5), rr = r & 15, cc = c & 31, ob = rr * 64 + cc * 2; return st * 1024 + (ob ^ (((ob >> 9) & 1) << 5)); }
DI void stage_rc(int b, int& R, int& C) { const int st = b / 1024, sb = b % 1024, swz = sb ^ (((sb >> 9) & 1) << 5); R = (st >> 1) * 16 + swz / 64; C = (st & 1) * 32 + (swz % 64) / 2; }
DI int perm32(int rho) { const int n = rho >> 4, i = rho & 15; return 8 * (i >> 2) + 4 * n + (i & 3); }

struct UnitD { const char* A; const char* B; unsigned lda2, ldb2; int nt; int pm, pn, aux; };

struct TileOrder {
    int nM, nN, nwg, G, c;
    DI void init(int M, int N, int G_, int c_) { nM = M / BM; nN = N / BM; nwg = nM * nN; G = G_; c = c_; }
    DI bool tile(int i, int& pm, int& pn) const {
        const long L = (long)i * G + c; if (L >= nwg) return false;
        int wgid = (int)L; { const int q = nwg / NXCD, r = nwg % NXCD, xcd = wgid % NXCD, off = wgid / NXCD; wgid = (xcd < r ? xcd * (q + 1) : r * (q + 1) + (xcd - r) * q) + off; }
        const int nig = WGM * nN, gid = wgid / nig, fm = gid * WGM, gsz = (nM - fm) < WGM ? (nM - fm) : WGM;
        pm = fm + ((wgid % nig) % gsz); pn = (wgid % nig) / gsz; return true;
    }
};
struct SchedPlain {
    static constexpr bool UNIFORM_LD = true;
    TileOrder o; const char* A; const char* B; unsigned lda2, ldb2; int nt; size_t astride;
    DI bool get(int i, UnitD& u) const { int pm, pn; if (!o.tile(i, pm, pn)) return false; u.pm = pm; u.pn = pn; u.aux = 0;
        u.A = A + (size_t)pm * astride; u.B = B + (size_t)pn * BM * ldb2; u.lda2 = lda2; u.ldb2 = ldb2; u.nt = nt; return true; }
};
struct SchedBO {
    static constexpr bool UNIFORM_LD = false;
    TileOrder o; const char* XB; const char* PM; const char* WgT; const char* WboT;
    DI bool get(int i, UnitD& u) const { const int ti = i / 6, sub = i - ti * 6, br = sub >> 1; int pm, pn; if (!o.tile(ti, pm, pn)) return false; u.pm = pm; u.pn = pn; u.aux = sub;
        if ((sub & 1) == 0) { u.A = XB + (size_t)pm * BM * 2048; u.lda2 = 2048; u.B = WgT + (size_t)(br * 1024 + pn * BM) * 2048; u.ldb2 = 2048; u.nt = 16; }
        else { const int yc = br == 0 ? 0 : (br == 1 ? 1536 : 2560); u.A = PM + (size_t)pm * BM * (PMP * 2) + yc * 2; u.lda2 = PMP * 2; u.B = WboT + (size_t)(br * 1024 + pn * BM) * 1024; u.ldb2 = 1024; u.nt = 8; }
        return true; }
};

DI void row_rs8(const float* part, int row0, int fq, float (&rs)[2][4]) {
    f32x4 v[2][4];
#pragma unroll
    for (int ai = 0; ai < 2; ++ai)
#pragma unroll
        for (int m = 0; m < 4; ++m) v[ai][m] = *((const f32x4*)(part + (size_t)(row0 + ai * HALF + m * 16) * 16) + fq);
#pragma unroll
    for (int ai = 0; ai < 2; ++ai)
#pragma unroll
        for (int m = 0; m < 4; ++m) { float s_ = (v[ai][m][0] + v[ai][m][1]) + (v[ai][m][2] + v[ai][m][3]); s_ += __shfl_xor(s_, 16); s_ += __shfl_xor(s_, 32); rs[ai][m] = 1.0f / sqrtf(s_ * (1.0f / 1024.0f) + EPS); }
}
template <class Epi, class Sched>
DI void gemm_phase(LAS unsigned char* lds, const Sched& S, const Epi& E) {
    int tid_ = threadIdx.x; asm volatile("" : "+v"(tid_)); const int tid = tid_, wid = __builtin_amdgcn_readfirstlane(tid >> 6), lane = tid & 63, wr = wid >> 2, wc = wid & 3, fr = lane & 15, fq = lane >> 4;
#define PG8_VOFFS(lda_, ldb_, oA0, oA1, oB0, oB1) do { int t2_ = tid; asm volatile("" : "+v"(t2_)); int R0_, C0_, R1_, C1_; stage_rc(t2_ * 16, R0_, C0_); stage_rc(t2_ * 16 + 8192, R1_, C1_); \
        const int Rb0_ = (R0_ & ~31) + perm32(R0_ & 31), Rb1_ = (R1_ & ~31) + perm32(R1_ & 31); \
        oA0 = (unsigned)R0_ * (lda_) + C0_ * 2; oA1 = (unsigned)R1_ * (lda_) + C1_ * 2; oB0 = (unsigned)Rb0_ * (ldb_) + C0_ * 2; oB1 = (unsigned)Rb1_ * (ldb_) + C1_ * 2; } while (0)
    const size_t kstep = (size_t)(BK * 2);
    const unsigned ldsw = (unsigned)wid * 1024u;
    const int aoff = lds_byte(wr * 64 + fr, fq * 8), boff = lds_byte(wc * 32 + fr, fq * 8);
#define PG8_SA(b, h) (((b) * 2 + (h)) * HTB)
#define PG8_SB(b, h) ((4 + (b) * 2 + (h)) * HTB)
#define PG8_STAGE(bufoff, gbase, v0, v1) do { \
        __builtin_amdgcn_global_load_lds((const unsigned*)((const char*)(gbase) + (v0)), (LAS unsigned*)(lds + (bufoff) + ldsw), 16, 0, 0); \
        __builtin_amdgcn_global_load_lds((const unsigned*)((const char*)(gbase) + (v1)), (LAS unsigned*)(lds + (bufoff) + ldsw + 8192), 16, 0, 0); } while (0)
#define PG8_LDA(dst, b, h) do { _Pragma("unroll") for (int m = 0; m < 4; ++m) _Pragma("unroll") for (int k = 0; k < 2; ++k) dst[m][k] = *(const LAS bf16x8*)(lds + PG8_SA(b, h) + aoff + m * 2048 + k * 1024); } while (0)
#define PG8_LDB(dst, b, h) do { _Pragma("unroll") for (int n = 0; n < 2; ++n) _Pragma("unroll") for (int k = 0; k < 2; ++k) dst[n][k] = *(const LAS bf16x8*)(lds + PG8_SB(b, h) + boff + n * 2048 + k * 1024); } while (0)
#define PG8_MMA(ai, bj, At, Bt) do { __builtin_amdgcn_s_setprio(1); _Pragma("unroll") for (int m = 0; m < 4; ++m) _Pragma("unroll") for (int n = 0; n < 2; ++n) _Pragma("unroll") for (int k = 0; k < 2; ++k) \
        acc[ai][bj][m][n] = __builtin_amdgcn_mfma_f32_16x16x32_bf16(Bt[n][k], At[m][k], acc[ai][bj][m][n], 0, 0, 0); __builtin_amdgcn_s_setprio(0); } while (0)
#define PG8_WAIT_V(n) asm volatile("s_waitcnt vmcnt(" #n ")" ::: "memory")
#define PG8_WAIT_L(n) asm volatile("s_waitcnt lgkmcnt(" #n ")" ::: "memory")
#define PG8_BAR __builtin_amdgcn_s_barrier()
#define PG8_SCHED __builtin_amdgcn_sched_barrier(0)
    UnitD cur, nxt; int ui = 0;
    if (!S.get(0, cur)) return;
    float rsc[2][4]; int rs_pm = cur.pm;
    if constexpr (Epi::NEEDS_RS) row_rs8(E.part, cur.pm * BM + wr * 64 + fr, fq, rsc);
    f32x4 acc[2][2][4][2];
#pragma unroll
    for (int a = 0; a < 2; ++a)
#pragma unroll
        for (int b = 0; b < 2; ++b)
#pragma unroll
            for (int m = 0; m < 4; ++m)
#pragma unroll
                for (int n = 0; n < 2; ++n) acc[a][b][m][n] = (f32x4){0.f, 0.f, 0.f, 0.f};
    bf16x8 At[4][2], B0[2][2], B1[2][2];
    const char* cA = cur.A; const char* cB = cur.B;
    unsigned vA0, vA1, vB0, vB1; PG8_VOFFS(cur.lda2, cur.ldb2, vA0, vA1, vB0, vB1);
    size_t hA = (size_t)HALF * cur.lda2, hB = (size_t)HALF * cur.ldb2;
    PG8_STAGE(PG8_SB(0, 0), cB, vB0, vB1); PG8_STAGE(PG8_SB(0, 1), cB + hB, vB0, vB1); PG8_STAGE(PG8_SA(0, 0), cA, vA0, vA1); PG8_STAGE(PG8_SA(0, 1), cA + hA, vA0, vA1);
    if (wr == 1) PG8_BAR;
    PG8_WAIT_V(2); PG8_BAR;
    PG8_STAGE(PG8_SB(1, 0), cB + kstep, vB0, vB1); PG8_STAGE(PG8_SA(1, 0), cA + kstep, vA0, vA1); PG8_STAGE(PG8_SB(1, 1), cB + hB + kstep, vB0, vB1);
    PG8_WAIT_V(6); PG8_BAR;
    for (;;) {
        const bool has_next = S.get(ui + 1, nxt);
        const char* nA = has_next ? nxt.A : cA; const char* nB = has_next ? nxt.B : cB;
        unsigned nvA0 = vA0, nvA1 = vA1, nvB0 = vB0, nvB1 = vB1; size_t nhA = hA, nhB = hB;
        if constexpr (!Sched::UNIFORM_LD) {
            const unsigned nlda = has_next ? nxt.lda2 : cur.lda2, nldb = has_next ? nxt.ldb2 : cur.ldb2;
            PG8_VOFFS(nlda, nldb, nvA0, nvA1, nvB0, nvB1); nhA = (size_t)HALF * nlda; nhB = (size_t)HALF * nldb;
        }
        const int nt = cur.nt;
        for (int t = 0; t < nt; t += 2) {
            const bool last = (t == nt - 2);
            const char* a1 = cA + (size_t)(t + 1) * kstep;
            const char* a2 = last ? nA : cA + (size_t)(t + 2) * kstep; const char* b2 = last ? nB : cB + (size_t)(t + 2) * kstep;
            const char* a3 = a2 + kstep; const char* b3 = b2 + kstep;
            const unsigned xA0 = last ? nvA0 : vA0, xA1 = last ? nvA1 : vA1, xB0 = last ? nvB0 : vB0, xB1 = last ? nvB1 : vB1;
            const size_t xhA = last ? nhA : hA, xhB = last ? nhB : hB;
            PG8_LDB(B0, 0, 0); PG8_LDB(B1, 0, 1); PG8_SCHED; PG8_LDA(At, 0, 0); PG8_STAGE(PG8_SA(1, 1), a1 + hA, vA0, vA1);
            PG8_WAIT_V(8); PG8_WAIT_L(0); PG8_BAR; PG8_MMA(0, 0, At, B0); PG8_MMA(0, 1, At, B1); PG8_BAR; PG8_SCHED;
            PG8_LDA(At, 0, 1); PG8_STAGE(PG8_SB(0, 0), b2, xB0, xB1); PG8_STAGE(PG8_SB(0, 1), b2 + xhB, xB0, xB1); PG8_STAGE(PG8_SA(0, 0), a2, xA0, xA1);
            PG8_WAIT_V(8); PG8_WAIT_L(0); PG8_BAR; PG8_MMA(1, 0, At, B0); PG8_MMA(1, 1, At, B1); PG8_BAR; PG8_SCHED;
            PG8_LDB(B0, 1, 0); PG8_LDB(B1, 1, 1); PG8_SCHED; PG8_LDA(At, 1, 0); PG8_STAGE(PG8_SA(0, 1), a2 + xhA, xA0, xA1);
            PG8_WAIT_V(8); PG8_WAIT_L(0); PG8_BAR; PG8_MMA(0, 0, At, B0); PG8_MMA(0, 1, At, B1); PG8_BAR; PG8_SCHED;
            PG8_LDA(At, 1, 1); PG8_STAGE(PG8_SB(1, 0), b3, xB0, xB1); PG8_STAGE(PG8_SB(1, 1), b3 + xhB, xB0, xB1); PG8_STAGE(PG8_SA(1, 0), a3, xA0, xA1);
            PG8_WAIT_V(8); PG8_WAIT_L(0); PG8_BAR; PG8_MMA(1, 0, At, B0); PG8_MMA(1, 1, At, B1); PG8_BAR; PG8_SCHED;
        }
        if (wr == 0) PG8_BAR;
        if constexpr (Epi::NEEDS_RS) { if (cur.pm != rs_pm) { row_rs8(E.part, cur.pm * BM + wr * 64 + fr, fq, rsc); rs_pm = cur.pm; } E(acc, cur, wr, wc, fr, fq, rsc); }
        else E(acc, cur, wr, wc, fr, fq);
        if (!has_next) break;
#pragma unroll
        for (int a = 0; a < 2; ++a)
#pragma unroll
            for (int b = 0; b < 2; ++b)
#pragma unroll
                for (int m = 0; m < 4; ++m)
#pragma unroll
                    for (int n = 0; n < 2; ++n) acc[a][b][m][n] = (f32x4){0.f, 0.f, 0.f, 0.f};
        cur = nxt; cA = nA; cB = nB; ++ui; vA0 = nvA0; vA1 = nvA1; vB0 = nvB0; vB1 = nvB1; hA = nhA; hB = nhB;
        if (wr == 1) PG8_BAR;
    }
    PG8_WAIT_V(0);
    PG8_BAR;
#undef PG8_VOFFS
#undef PG8_SA
#undef PG8_SB
#undef PG8_STAGE
#undef PG8_LDA
#undef PG8_LDB
#undef PG8_MMA
#undef PG8_WAIT_V
#undef PG8_WAIT_L
#undef PG8_BAR
#undef PG8_SCHED
}

DI u32x4 pk8(const f32x4 v0, const f32x4 v1) { u32x4 w; w.x = cvt_pk_bf16(v0[0], v0[1]); w.y = cvt_pk_bf16(v0[2], v0[3]); w.z = cvt_pk_bf16(v1[0], v1[1]); w.w = cvt_pk_bf16(v1[2], v1[3]); return w; }

struct EpiMain {
    static constexpr bool NEEDS_RS = true;
    bf16_t* PM; const float* part; float* rsv;
    DI void operator()(const f32x4 (&acc)[2][2][4][2], const UnitD& u, int wr, int wc, int fr, int fq, const float (&rs)[2][4]) const {
        const int row0 = u.pm * BM + wr * 64 + fr, col0 = u.pn * BM + wc * 32 + 8 * fq; const bool gl = (u.pn >= 6 && u.pn < 10);
#pragma unroll
        for (int ai = 0; ai < 2; ++ai)
#pragma unroll
            for (int m = 0; m < 4; ++m) { const int row = row0 + ai * HALF + m * 16; const float r_ = rs[ai][m]; bf16_t* rowp = PM + (size_t)row * PMP + col0;
                if (u.pn == 0 && wc == 0 && fq == 0) rsv[row] = r_;
                if (u.pn >= 2 && u.pn < 6) {
                    float o[8];
#pragma unroll
                    for (int n = 0; n < 2; ++n) { const f32x4 cg = acc[ai][0][m][n] * r_, xa = acc[ai][1][m][n] * r_;
#pragma unroll
                        for (int e = 0; e < 4; ++e) o[4 * n + e] = cg[e] * xa[e]; }
                    *(u32x4*)(PM + (size_t)row * PMP + 512 + 128 * (u.pn - 2) + wc * 32 + 8 * fq) = pack8(o);
                } else {
#pragma unroll
                for (int bj = 0; bj < 2; ++bj) { f32x4 v0 = acc[ai][bj][m][0] * r_, v1 = acc[ai][bj][m][1] * r_; if (gl) { v0 = gelu4(v0); v1 = gelu4(v1); }
                    *(u32x4*)(rowp + bj * HALF) = pk8(v0, v1); } } }
    }
};
struct EpiBO {
    static constexpr bool NEEDS_RS = false;
    bf16_t* PM; const float* rsv; const float* bgate;
    DI void operator()(const f32x4 (&acc)[2][2][4][2], const UnitD& u, int wr, int wc, int fr, int fq) const {
        const int row0 = u.pm * BM + wr * 64 + fr, col0 = u.pn * BM + wc * 32 + 8 * fq, br = u.aux >> 1;
        if ((u.aux & 1) == 0) {
            f32x4 bv[2][2]; float rs[2][4];
#pragma unroll
            for (int bj = 0; bj < 2; ++bj)
#pragma unroll
                for (int n = 0; n < 2; ++n) bv[bj][n] = *(const f32x4*)(bgate + br * 1024 + col0 + bj * HALF + 4 * n);
#pragma unroll
            for (int ai = 0; ai < 2; ++ai)
#pragma unroll
                for (int m = 0; m < 4; ++m) rs[ai][m] = rsv[row0 + ai * HALF + m * 16];
#pragma unroll
            for (int ai = 0; ai < 2; ++ai)
#pragma unroll
                for (int m = 0; m < 4; ++m) { const int row = row0 + ai * HALF + m * 16; const float r_ = rs[ai][m];
#pragma unroll
                    for (int bj = 0; bj < 2; ++bj) { f32x4 v0 = acc[ai][bj][m][0] * r_ + bv[bj][0], v1 = acc[ai][bj][m][1] * r_ + bv[bj][1];
                        unsigned q0 = 0u, q1 = 0u;
#pragma unroll
                        for (int e = 0; e < 4; ++e) { q0 |= (unsigned)(sigmoidf_(v0[e]) * 255.0f + 0.5f) << (8 * e); q1 |= (unsigned)(sigmoidf_(v1[e]) * 255.0f + 0.5f) << (8 * e); }
                        *(u32x2*)((unsigned char*)(PM + (size_t)row * PMP + COL_GS) + col0 + bj * HALF) = (u32x2){q0, q1}; } }
        } else {
#pragma unroll
            for (int ai = 0; ai < 2; ++ai) {
                u32x2 gw[4][2]; u32x4 mw[4][2];
#pragma unroll
                for (int m = 0; m < 4; ++m)
#pragma unroll
                    for (int bj = 0; bj < 2; ++bj) { const size_t rr_ = (size_t)(row0 + ai * HALF + m * 16) * PMP, ro = rr_ + col0 + bj * HALF; gw[m][bj] = *(const u32x2*)((const unsigned char*)(PM + rr_ + COL_GS) + col0 + bj * HALF); mw[m][bj] = (br > 0) ? *(const u32x4*)(PM + ro + COL_MG) : (u32x4){0u, 0u, 0u, 0u}; }
#pragma unroll
                for (int m = 0; m < 4; ++m)
#pragma unroll
                    for (int bj = 0; bj < 2; ++bj) { float g[8], o[8], pv_[8]; unpack8(mw[m][bj], pv_);
#pragma unroll
                        for (int e = 0; e < 4; ++e) { g[e] = (float)((gw[m][bj].x >> (8 * e)) & 0xffu) * (1.0f / 255.0f); g[4 + e] = (float)((gw[m][bj].y >> (8 * e)) & 0xffu) * (1.0f / 255.0f); }
                        const f32x4 a0 = acc[ai][bj][m][0], a1 = acc[ai][bj][m][1];
#pragma unroll
                        for (int e = 0; e < 4; ++e) { o[e] = a0[e] * g[e] + pv_[e]; o[4 + e] = a1[e] * g[4 + e] + pv_[4 + e]; }
                        *(u32x4*)(PM + (size_t)(row0 + ai * HALF + m * 16) * PMP + col0 + bj * HALF + COL_MG) = pack8(o); }
                asm volatile("" ::: "memory");
            }
        }
    }
};
struct EpiRes {
    static constexpr bool NEEDS_RS = false;
    float* out; bf16_t* XB; float* part;
    DI void operator()(const f32x4 (&acc)[2][2][4][2], const UnitD& u, int wr, int wc, int fr, int fq) const {
        const int row0 = u.pm * BM + wr * 64 + fr, col0 = u.pn * BM + wc * 32 + 8 * fq;
        u32x4 xw[2][4][2];
#pragma unroll
        for (int ai = 0; ai < 2; ++ai)
#pragma unroll
            for (int m = 0; m < 4; ++m)
#pragma unroll
                for (int bj = 0; bj < 2; ++bj) xw[ai][m][bj] = *(const u32x4*)(XB + (size_t)(row0 + ai * HALF + m * 16) * D_ + col0 + bj * HALF);
#pragma unroll
        for (int ai = 0; ai < 2; ++ai)
#pragma unroll
            for (int m = 0; m < 4; ++m) { const int row = row0 + ai * HALF + m * 16; const size_t off = (size_t)row * D_ + col0; float ss = 0.f;
#pragma unroll
                for (int bj = 0; bj < 2; ++bj) { float b[8]; unpack8(xw[ai][m][bj], b);
                    const f32x4 a0 = acc[ai][bj][m][0], a1 = acc[ai][bj][m][1];
                    const f32x4 x0 = (f32x4){b[0] + a0[0], b[1] + a0[1], b[2] + a0[2], b[3] + a0[3]}, x1 = (f32x4){b[4] + a1[0], b[5] + a1[1], b[6] + a1[2], b[7] + a1[3]};
                    if (out) { *(f32x4*)(out + off + bj * HALF) = x0; *(f32x4*)(out + off + bj * HALF + 4) = x1; }
                    else { *(u32x4*)(XB + off + bj * HALF) = pk8(x0, x1);
                        ss += ((x0[0] * x0[0] + x0[1] * x0[1]) + (x0[2] * x0[2] + x0[3] * x0[3])) + ((x1[0] * x1[0] + x1[1] * x1[1]) + (x1[2] * x1[2] + x1[3] * x1[3])); } }
                if (!out) { ss += __shfl_xor(ss, 16); ss += __shfl_xor(ss, 32);
                    if (fq == 0) part[(size_t)row * 16 + u.pn * 4 + wc] = ss; } }
    }
};
struct EpiGU {
    static constexpr bool NEEDS_RS = true;
    bf16_t* ACT; const float* part;
    DI void operator()(const f32x4 (&acc)[2][2][4][2], const UnitD& u, int wr, int wc, int fr, int fq, const float (&rs)[2][4]) const {
        const int row0 = u.pm * BM + wr * 64 + fr, col0 = u.pn * HALF + wc * 32 + 8 * fq;
#pragma unroll
        for (int ai = 0; ai < 2; ++ai)
#pragma unroll
            for (int m = 0; m < 4; ++m) { const int row = row0 + ai * HALF + m * 16; const float r_ = rs[ai][m]; float o[8];
#pragma unroll
                for (int n = 0; n < 2; ++n) { const f32x4 g = acc[ai][0][m][n] * r_, uu = acc[ai][1][m][n] * r_;
#pragma unroll
                    for (int e = 0; e < 4; ++e) o[4 * n + e] = g[e] * sigmoidf_(g[e]) * uu[e]; }
                *(u32x4*)(ACT + (size_t)(row >> 8) * ((size_t)PMP * 256) + (size_t)(row & 255) * DFF + col0) = pack8(o); }
    }
};
}

DI void transpose_item(const float* W, int N, int Kd, const float* kscale, bf16_t* WT, int k0, int n0, int drow0, LAS float* scr, int lane) {
    const int kq = lane >> 4, nq = (lane & 15) * 4;
    f32x4 v[16];
#pragma unroll
    for (int i = 0; i < 16; ++i) v[i] = *(const f32x4*)(W + (size_t)(k0 + 4 * i + kq) * N + n0 + nq);
#pragma unroll
    for (int i = 0; i < 16; ++i) { const int kk = 4 * i + kq; const float sc = kscale ? kscale[k0 + kk] : 1.0f; LAS float* d = scr + kk * 65 + nq;
        d[0] = v[i][0] * sc; d[1] = v[i][1] * sc; d[2] = v[i][2] * sc; d[3] = v[i][3] * sc; }
    asm volatile("s_waitcnt lgkmcnt(0)" ::: "memory");
    const int c = lane & 7;
#pragma unroll
    for (int j = 0; j < 8; ++j) { const int n = (lane >> 3) + 8 * j; const LAS float* s_ = scr + (8 * c) * 65 + n;
        u32x4 o; o.x = cvt_pk_bf16(s_[0 * 65], s_[1 * 65]); o.y = cvt_pk_bf16(s_[2 * 65], s_[3 * 65]); o.z = cvt_pk_bf16(s_[4 * 65], s_[5 * 65]); o.w = cvt_pk_bf16(s_[6 * 65], s_[7 * 65]);
        *(u32x4*)(WT + (size_t)(drow0 + n) * Kd + k0 + 8 * c) = o; }
    asm volatile("s_waitcnt lgkmcnt(0)" ::: "memory");
}

struct Params {
    const float* x; const float* mix_g; const float* w_in; const float* b_gate; const float* conv_w; const float* conv_b;
    const float* ln_g; const float* ln_b; const float* sgu_w; const float* sgu_b; const float* qg; const float* kg;
    const float* w_bo; const float* w_o; const float* ffn_g; const float* w_gu; const float* w_dn;
    float* out; unsigned char* ws; int ph_lo, ph_hi;
};

constexpr int I_MAIN = 16 * 64, I_IN = 16 * 112, I_BO = 3 * 8 * 16, I_O = 16 * 16, I_GU = 16 * 88, I_DN = 44 * 16, I_REST = I_BO + I_O + I_GU + I_DN;
DI int win_row(int nb) { if (nb >= 8 && nb < 16) { const int cc = 64 * nb - 512; return 512 + 256 * (cc / 128) + (cc % 128); } if (nb >= 16 && nb < 24) { const int cc = 64 * nb - 1024; return 512 + 256 * (cc / 128) + 128 + (cc % 128); } return 64 * nb; }
DI void convert_items(const Params& p, LAS unsigned char* lds, int first, int count) {
    int tid_ = threadIdx.x; asm volatile("" : "+v"(tid_)); const int tid = tid_, lane = tid & 63, wave = tid >> 6;
    LAS float* scr = (LAS float*)(lds + wave * 16640);
    const int gw = blockIdx.x * 8 + wave, NGW = gridDim.x * 8;
    for (int it = first + gw; it < first + count; it += NGW) {
        if (it < 2 * I_IN) { int l, kb, nb;
            if (it < I_MAIN) { l = 0; kb = it / 64; nb = it % 64; }
            else if (it < I_IN) { const int r = it - I_MAIN; l = 0; kb = r / 48; nb = 64 + r % 48; }
            else { const int r = it - I_IN; l = 1; kb = r / 112; nb = r % 112; }
            unsigned char* wl = p.ws + (size_t)l * WS_WL;
            transpose_item(p.w_in + (size_t)l * D_ * NIN, NIN, 1024, p.mix_g + l * D_, (bf16_t*)(wl + W_IN), 64 * kb, 64 * nb, win_row(nb), scr, lane); continue; }
        const int q = it - 2 * I_IN, l = q / I_REST; int r = q - l * I_REST; unsigned char* wl = p.ws + (size_t)l * WS_WL;
        if (r < I_BO) { const int i = r / 128, rr = r % 128, kb = rr / 16, nb = rr % 16; transpose_item(p.w_bo + ((size_t)l * 3 + i) * 512 * 1024, 1024, 512, nullptr, (bf16_t*)(wl + W_BO) + (size_t)i * 1024 * 512, 64 * kb, 64 * nb, 64 * nb, scr, lane); continue; } r -= I_BO;
        if (r < I_O) { const int kb = r / 16, nb = r % 16; transpose_item(p.w_o + (size_t)l * 1024 * 1024, 1024, 1024, nullptr, (bf16_t*)(wl + W_O), 64 * kb, 64 * nb, 64 * nb, scr, lane); continue; } r -= I_O;
        if (r < I_GU) { const int kb = r / 88, nb = r % 88, n0 = 64 * nb, cc = n0 < DFF ? n0 : n0 - DFF, dr = 256 * (cc / 128) + (cc % 128) + (n0 < DFF ? 0 : 128);
            transpose_item(p.w_gu + (size_t)l * 1024 * NGU, NGU, 1024, p.ffn_g + l * D_, (bf16_t*)(wl + W_GU), 64 * kb, n0, dr, scr, lane); continue; } r -= I_GU;
        { const int kb = r / 16, nb = r % 16; transpose_item(p.w_dn + (size_t)l * DFF * 1024, 1024, DFF, nullptr, (bf16_t*)(wl + W_DN), 64 * kb, 64 * nb, 64 * nb, scr, lane); }
    }
}
DI void phase0(const Params& p, LAS unsigned char* lds, int mode, int row_base) {
    int tid_ = threadIdx.x; asm volatile("" : "+v"(tid_)); const int tid = tid_, lane = tid & 63, wave = tid >> 6;
    const int gw = blockIdx.x * 8 + wave, NGW = gridDim.x * 8;
    if (mode != 2) {
    convert_items(p, lds, 0, I_MAIN);
    for (int i = blockIdx.x * 512 + tid; i < 2 * 4 * 128 * 128; i += gridDim.x * 512) {
        const int l = i >> 16, rem = i & 65535, t = (rem >> 7) & 127, s = rem & 127; const float w = p.sgu_w[i];
        ((bf16_t*)(p.ws + (size_t)l * WS_WL + W_SG))[rem] = f2bf(s <= t ? w : 0.f);
    }
    }
    if (mode == 0) return;
    bf16_t* XB = (bf16_t*)(p.ws + WS_XB); float* part = (float*)(p.ws + WS_PART);
    const int mfirst = (mode == 2) ? row_base + wave * 8 : gw, mstep = (mode == 2) ? 1 : NGW, mend = (mode == 2) ? row_base + wave * 8 + 8 : T_;
    for (int m0 = mfirst; m0 < mend; m0 += 4 * mstep) {
        f32x4 v[4][4];
#pragma unroll
        for (int q = 0; q < 4; ++q) { const int m = m0 + q * mstep; const f32x4* xr = (const f32x4*)(p.x + (size_t)(m < mend ? m : m0) * D_) + lane;
#pragma unroll
            for (int j = 0; j < 4; ++j) v[q][j] = xr[64 * j]; }
#pragma unroll
        for (int q = 0; q < 4; ++q) { const int m = m0 + q * mstep; if (m < mend) { float ss = 0.f; u32x2* o8 = (u32x2*)(XB + (size_t)m * D_) + lane;
#pragma unroll
            for (int j = 0; j < 4; ++j) { const f32x4 w_ = v[q][j]; ss += (w_[0] * w_[0] + w_[1] * w_[1]) + (w_[2] * w_[2] + w_[3] * w_[3]); u32x2 w; w.x = cvt_pk_bf16(w_[0], w_[1]); w.y = cvt_pk_bf16(w_[2], w_[3]); o8[64 * j] = w; }
            ss = wave_sum(ss);
            if (lane < 16) part[(size_t)m * 16 + lane] = lane == 0 ? ss : 0.f; } }
    }
}

DI int crow(int r, int hi) { return (r & 3) + 8 * (r >> 2) + 4 * hi; }

constexpr int AT_K = 0, AT_V = 8192, AT_BUF = 16384, AT_FLAG = 32768, AT_OST = 32768 + 256;
DI void pv_acc(f32x16& o0, f32x16& o1, int vb, bf16x8 pa0, bf16x8 pa1, bf16x8 pa2, bf16x8 pa3) {
#pragma unroll
    for (int d0 = 0; d0 < 2; ++d0) { s16x4 lo[4], hi[4];
#pragma unroll
        for (int ks = 0; ks < 4; ++ks) {
            asm volatile("ds_read_b64_tr_b16 %0,%1 offset:%c2" : "=&v"(lo[ks]) : "v"(vb), "i"(d0 * 4096 + ks * 1024) : "memory");
            asm volatile("ds_read_b64_tr_b16 %0,%1 offset:%c2" : "=&v"(hi[ks]) : "v"(vb), "i"(d0 * 4096 + ks * 1024 + 512) : "memory"); }
        asm volatile("s_waitcnt lgkmcnt(0)" ::: "memory"); __builtin_amdgcn_sched_barrier(0);
#define PK(k) (bf16x8){lo[k][0], lo[k][1], lo[k][2], lo[k][3], hi[k][0], hi[k][1], hi[k][2], hi[k][3]}
        f32x16 o = d0 ? o1 : o0;
        o = __builtin_amdgcn_mfma_f32_32x32x16_bf16(pa0, PK(0), o, 0, 0, 0);
        o = __builtin_amdgcn_mfma_f32_32x32x16_bf16(pa1, PK(1), o, 0, 0, 0);
        o = __builtin_amdgcn_mfma_f32_32x32x16_bf16(pa2, PK(2), o, 0, 0, 0);
        o = __builtin_amdgcn_mfma_f32_32x32x16_bf16(pa3, PK(3), o, 0, 0, 0);
        if (d0) o1 = o; else o0 = o;
#undef PK
    }
}

DI void attn_unit(LAS unsigned char* lds, bf16_t* PM, const float* gq, const float* gk, int b, int h, int qb, bf16_t* dmy) {
    int tid_ = threadIdx.x; asm volatile("" : "+v"(tid_)); const int tid = tid_, lane = tid & 63, r32 = lane & 31, hi = lane >> 5, wid = __builtin_amdgcn_readfirstlane(tid >> 6);
    const int q0 = qb * 256; const size_t rowbase = (size_t)b * SEQ_;
    bf16x8 qr[4];
    {
        const bf16_t* Qp = PM + (rowbase + q0 + wid * 32 + r32) * PMP + 2560 + h * 64 + hi * 8;
        float qf[4][8]; float ss = 0.f;
#pragma unroll
        for (int d0 = 0; d0 < 4; ++d0) { unpack8(*(const u32x4*)(Qp + d0 * 16), qf[d0]);
#pragma unroll
            for (int e = 0; e < 8; ++e) ss += qf[d0][e] * qf[d0][e]; }
        ss += __shfl_xor(ss, 32);
        const float sc = C2 / sqrtf(ss * (1.0f / 64.0f) + EPS);
#pragma unroll
        for (int d0 = 0; d0 < 4; ++d0) { float t[8];
#pragma unroll
            for (int e = 0; e < 8; ++e) t[e] = qf[d0][e] * sc * gq[d0 * 16 + hi * 8 + e];
            qr[d0] = __builtin_bit_cast(bf16x8, pack8(t)); }
    }
    const int key = tid >> 3, ch = tid & 7;
    float gkv[8];
#pragma unroll
    for (int e = 0; e < 8; ++e) gkv[e] = gk[ch * 8 + e];
    const bf16_t* kvp = PM + (rowbase + key) * PMP + 3072 + h * 64 + ch * 8;
    LAS unsigned char* kdst = lds + AT_K + ch * 1024 + key * 16;
    LAS unsigned char* vdst = lds + AT_V + ((ch >> 2) * 4 + (key >> 4)) * 1024 + (key & 15) * 64 + (ch & 3) * 16;
    const LAS unsigned char* kb = lds + AT_K + hi * 1024 + r32 * 16;
    const int vb0 = (int)(unsigned)(uintptr_t)(lds + AT_V) + ((lane >> 4) & 1) * 32 + (lane & 3) * 8 + (4 * hi + ((lane & 15) >> 2)) * 64;
    volatile LAS unsigned* flags = (volatile LAS unsigned*)(lds + AT_FLAG);
    const int NT = (q0 + 256) / 64, wq0 = q0 + wid * 32, qi = wq0 + r32;
    float carry = 0.f; f32x16 o0, o1;
#pragma unroll
    for (int r = 0; r < 16; ++r) { o0[r] = 0.f; o1[r] = 0.f; }
    bool wdone = false;
#define AT_STAGE(kr, vr, bsel) do { float kf[8]; unpack8(kr, kf); float ss_ = 0.f; \
        _Pragma("unroll") for (int e = 0; e < 8; ++e) ss_ += kf[e] * kf[e]; \
        ss_ += __shfl_xor(ss_, 1); ss_ += __shfl_xor(ss_, 2); ss_ += __shfl_xor(ss_, 4); \
        const float sc_ = 1.0f / sqrtf(ss_ * (1.0f / 64.0f) + EPS); \
        _Pragma("unroll") for (int e = 0; e < 8; ++e) kf[e] = kf[e] * sc_ * gkv[e]; \
        *(LAS u32x4*)(kdst + (bsel) * AT_BUF) = pack8(kf); *(LAS u32x4*)(vdst + (bsel) * AT_BUF) = vr; } while (0)
    u32x4 kraw = *(const u32x4*)(kvp + (size_t)(NT - 1) * 64 * PMP), vraw = *(const u32x4*)(kvp + (size_t)(NT - 1) * 64 * PMP + 512);
    __syncthreads();
    AT_STAGE(kraw, vraw, (NT - 1) & 1);
    if (NT > 1) { kraw = *(const u32x4*)(kvp + (size_t)(NT - 2) * 64 * PMP); vraw = *(const u32x4*)(kvp + (size_t)(NT - 2) * 64 * PMP + 512); }
    for (int jt = NT - 1; jt >= 0; --jt) {
        __syncthreads();
        if (jt < NT - 1) { unsigned all = 1u;
#pragma unroll
            for (int w = 0; w < 8; ++w) all &= flags[((jt + 1) & 1) * 8 + w];
            if (all) break; }
        if (jt > 0) { AT_STAGE(kraw, vraw, (jt - 1) & 1);
            if (jt > 1) { kraw = *(const u32x4*)(kvp + (size_t)(jt - 2) * 64 * PMP); vraw = *(const u32x4*)(kvp + (size_t)(jt - 2) * 64 * PMP + 512); } }
        const int bo_ = (jt & 1) * AT_BUF;
        const int k0 = jt * 64;
        if (!wdone && k0 <= wq0) {
            f32x16 p0, p1;
#pragma unroll
            for (int r = 0; r < 16; ++r) { p0[r] = 0.f; p1[r] = 0.f; }
#pragma unroll
            for (int d0 = 0; d0 < 4; ++d0) { const bf16x8 b0 = *(const LAS bf16x8*)(kb + bo_ + d0 * 2048), b1 = *(const LAS bf16x8*)(kb + bo_ + d0 * 2048 + 512);
                p0 = __builtin_amdgcn_mfma_f32_32x32x16_bf16(b0, qr[d0], p0, 0, 0, 0); p1 = __builtin_amdgcn_mfma_f32_32x32x16_bf16(b1, qr[d0], p1, 0, 0, 0); }
            const bool needmask = (k0 + 63 >= wq0);
            float Lr[32], lb[32];
            if (needmask) {
#pragma unroll
                for (int i = 0; i < 32; ++i) { const float z = i < 16 ? p0[i] : p1[i - 16]; const int r = i & 15;
                    const float e = __builtin_amdgcn_exp2f(-fabsf(z)); const float sp = fmaxf(z, 0.f) + __builtin_amdgcn_logf(1.0f + e);
                    const bool valid = (k0 + (i >> 4) * 32 + crow(r, hi) < qi);
                    Lr[i] = valid ? -sp : 0.f; lb[i] = valid ? z - sp : -INFINITY; }
            } else {
#pragma unroll
                for (int i = 0; i < 32; ++i) { const float z = i < 16 ? p0[i] : p1[i - 16];
                    const float e = __builtin_amdgcn_exp2f(-fabsf(z)); const float sp = fmaxf(z, 0.f) + __builtin_amdgcn_logf(1.0f + e);
                    Lr[i] = -sp; lb[i] = z - sp; }
            }
            float Tj[8], ex[8];
#pragma unroll
            for (int j = 0; j < 8; ++j) { const float g = (Lr[4 * j] + Lr[4 * j + 1]) + (Lr[4 * j + 2] + Lr[4 * j + 3]);
                auto rr = __builtin_amdgcn_permlane32_swap(__float_as_uint(g), __float_as_uint(g), false, false);
                const float lo = __uint_as_float(rr[0]), hv = __uint_as_float(rr[1]); Tj[j] = lo + hv; ex[j] = hi ? 0.f : hv; }
            float suf = carry; float w[32];
#pragma unroll
            for (int j = 7; j >= 0; --j) { const float a3 = suf + ex[j], a2 = a3 + Lr[4 * j + 3], a1 = a2 + Lr[4 * j + 2], a0 = a1 + Lr[4 * j + 1];
                w[4 * j + 3] = __builtin_amdgcn_exp2f(lb[4 * j + 3] + a3); w[4 * j + 2] = __builtin_amdgcn_exp2f(lb[4 * j + 2] + a2);
                w[4 * j + 1] = __builtin_amdgcn_exp2f(lb[4 * j + 1] + a1); w[4 * j] = __builtin_amdgcn_exp2f(lb[4 * j] + a0);
                suf += Tj[j]; }
            carry = suf;
            wdone = __all(carry < THR2) != 0;
            const bf16x8 pa0 = __builtin_bit_cast(bf16x8, pack8(w)), pa1 = __builtin_bit_cast(bf16x8, pack8(w + 8)), pa2 = __builtin_bit_cast(bf16x8, pack8(w + 16)), pa3 = __builtin_bit_cast(bf16x8, pack8(w + 24));
            pv_acc(o0, o1, vb0 + bo_, pa0, pa1, pa2, pa3);
        }
        if (lane == 0) flags[(jt & 1) * 8 + wid] = wdone ? 1u : 0u;
    }
#undef AT_STAGE
    {
        LAS bf16_t* stg = (LAS bf16_t*)(lds + AT_OST) + wid * 2048;
#pragma unroll
        for (int r = 0; r < 16; ++r) { const int orow = crow(r, hi); stg[orow * 64 + r32] = f2bf(o0[r]); stg[orow * 64 + 32 + r32] = f2bf(o1[r]); }
        asm volatile("s_waitcnt lgkmcnt(0)" ::: "memory");
        bf16_t* Ow = PM + (rowbase + q0 + wid * 32) * PMP + 2560 + h * 64; size_t opitch = PMP;
        if (dmy) { Ow = dmy + (rowbase + q0 + wid * 32) * 512 + h * 64; opitch = 512; }
#pragma unroll
        for (int i = 0; i < 4; ++i) { const int row = i * 8 + (lane >> 3), c8 = lane & 7; const u32x4 v = *(const LAS u32x4*)(stg + row * 64 + c8 * 8); *(u32x4*)(Ow + (size_t)row * opitch + c8 * 8) = v; }
        asm volatile("s_waitcnt lgkmcnt(0)" ::: "memory");
    }
}

DI void sgu_unit(LAS unsigned char* lds, bf16_t* PM, const bf16_t* WsT, const float* lng, const float* lnb, const float* sb, int chunk, int g, bf16_t* dmy) {
    int tid_ = threadIdx.x; asm volatile("" : "+v"(tid_)); const int tid = tid_, lane = tid & 63, r32 = lane & 31, hi = lane >> 5, wid = __builtin_amdgcn_readfirstlane(tid >> 6);
    LAS bf16_t* vT = (LAS bf16_t*)lds;
    LAS float* dstf = (LAS float*)(lds + 36864);
    const size_t tok0 = (size_t)chunk * 128;
    const int tb = wid & 3, chh = wid >> 2;
    const bf16_t* Ap = WsT + (size_t)g * 16384 + (32 * tb + r32) * 128 + 8 * hi;
    bf16x8 Afr[8];
#pragma unroll
    for (int ks = 0; ks < 8; ++ks) { if (ks < 2 * (tb + 1)) Afr[ks] = *(const bf16x8*)(Ap + 16 * ks); else Afr[ks] = (bf16x8){0, 0, 0, 0, 0, 0, 0, 0}; }
    const int er = tid >> 4, ep = tid & 15;
    bf16_t* ubase = PM + (tok0 + er) * PMP + 1536 + 128 * g + 8 * ep;
    u32x4 uraw[4];
#pragma unroll
    for (int i = 0; i < 4; ++i) uraw[i] = *(const u32x4*)(ubase + (size_t)(32 * i) * PMP);
    u32x4 vr[16];
#pragma unroll
    for (int i = 0; i < 16; ++i) vr[i] = *(const u32x4*)(PM + (tok0 + 16 * wid + i) * PMP + 2048 + 8 * lane);
    const int s_ = tid >> 2, qd = tid & 3;
    u32x4 gr[4];
#pragma unroll
    for (int i = 0; i < 4; ++i) gr[i] = *(const u32x4*)(PM + (tok0 + s_) * PMP + 2048 + 128 * g + 32 * qd + 8 * i);
    __syncthreads();
    LAS f32x2* red = (LAS f32x2*)(lds + 36864) + wid * (16 * 65);
#pragma unroll
    for (int i = 0; i < 16; ++i) { float f[8]; unpack8(vr[i], f); float sm = 0.f, sq = 0.f;
#pragma unroll
        for (int e = 0; e < 8; ++e) { sm += f[e]; sq += f[e] * f[e]; }
        red[i * 65 + lane] = (f32x2){sm, sq}; }
    f32x2 mr;
    {
        __builtin_amdgcn_fence(__ATOMIC_RELEASE, "wavefront"); __builtin_amdgcn_wave_barrier(); __builtin_amdgcn_fence(__ATOMIC_ACQUIRE, "wavefront");
        f32x2 ac = {0.f, 0.f}; const LAS f32x2* rp = red + (lane >> 2) * 65 + (lane & 3) * 16;
#pragma unroll
        for (int j = 0; j < 16; ++j) ac += rp[j];
        ac.x += __shfl_xor(ac.x, 1); ac.y += __shfl_xor(ac.y, 1); ac.x += __shfl_xor(ac.x, 2); ac.y += __shfl_xor(ac.y, 2);
        const float mean = ac.x * (1.0f / 512.0f), var = fmaxf(ac.y * (1.0f / 512.0f) - mean * mean, 0.f);
        mr = (f32x2){mean, 1.0f / sqrtf(var + EPS)};
    }
    {
#pragma unroll
        for (int i = 0; i < 4; ++i) { const int c0 = 32 * qd + 8 * i; float f[8]; unpack8(gr[i], f);
            const f32x4 g0 = *(const f32x4*)(lng + 128 * g + c0), g1 = *(const f32x4*)(lng + 128 * g + c0 + 4), b0 = *(const f32x4*)(lnb + 128 * g + c0), b1 = *(const f32x4*)(lnb + 128 * g + c0 + 4);
#pragma unroll
            for (int e = 0; e < 4; ++e) { vT[(c0 + e) * 136 + s_] = f2bf((f[e] - mr.x) * mr.y * g0[e] + b0[e]); vT[(c0 + 4 + e) * 136 + s_] = f2bf((f[4 + e] - mr.x) * mr.y * g1[e] + b1[e]); } }
    }
    __syncthreads();
    f32x16 a0, a1;
#pragma unroll
    for (int r = 0; r < 16; ++r) { a0[r] = 0.f; a1[r] = 0.f; }
    const LAS bf16_t* Bp = vT + (64 * chh + r32) * 136 + 8 * hi;
#pragma unroll
    for (int ks = 0; ks < 8; ++ks) { if (ks < 2 * (tb + 1)) {
        const bf16x8 B0 = *(const LAS bf16x8*)(Bp + 16 * ks), B1 = *(const LAS bf16x8*)(Bp + 32 * 136 + 16 * ks);
        a0 = __builtin_amdgcn_mfma_f32_32x32x16_bf16(Afr[ks], B0, a0, 0, 0, 0); a1 = __builtin_amdgcn_mfma_f32_32x32x16_bf16(Afr[ks], B1, a1, 0, 0, 0); } }
#pragma unroll
    for (int r = 0; r < 16; ++r) { const int t = 32 * tb + crow(r, hi); const float bias = sb[g * 128 + t];
        dstf[t * 132 + 64 * chh + r32] = a0[r] + bias; dstf[t * 132 + 64 * chh + 32 + r32] = a1[r] + bias; }
    __syncthreads();
#pragma unroll
    for (int i = 0; i < 4; ++i) { const int t = er + 32 * i; float u[8], o[8]; unpack8(uraw[i], u);
        const f32x4 m0 = *(const LAS f32x4*)(dstf + t * 132 + 8 * ep), m1 = *(const LAS f32x4*)(dstf + t * 132 + 8 * ep + 4);
#pragma unroll
        for (int e = 0; e < 4; ++e) { o[e] = u[e] * m0[e]; o[4 + e] = u[4 + e] * m1[e]; }
        bf16_t* op = dmy ? dmy + (tok0 + t) * 512 + 128 * g + 8 * ep : ubase + (size_t)(32 * i) * PMP;
        *(u32x4*)op = pack8(o); }
}

DI void conv_unit(bf16_t* PM, const float* cw, const float* cb, int tile, bf16_t* dmy) {
    int tid_ = threadIdx.x; asm volatile("" : "+v"(tid_)); const int tid = tid_, lane = tid & 63, wid = tid >> 6; const int tok_s = tile * 64 + wid * 8, c0 = lane * 8;
    float w0[8], w1[8], w2[8], bb[8], um2[8], um1[8];
#pragma unroll
    for (int e = 0; e < 8; ++e) { w0[e] = cw[c0 + e]; w1[e] = cw[512 + c0 + e]; w2[e] = cw[1024 + c0 + e]; bb[e] = cb[c0 + e]; um2[e] = 0.f; um1[e] = 0.f; }
    const int pos0 = tok_s % SEQ_;
    if (pos0 >= 2) unpack8(*(const u32x4*)(PM + (size_t)(tok_s - 2) * PMP + 512 + c0), um2);
    if (pos0 >= 1) unpack8(*(const u32x4*)(PM + (size_t)(tok_s - 1) * PMP + 512 + c0), um1);
    u32x4 ru[8], rg[8];
#pragma unroll
    for (int t = 0; t < 8; ++t) { const bf16_t* row = PM + (size_t)(tok_s + t) * PMP; ru[t] = *(const u32x4*)(row + 512 + c0); rg[t] = *(const u32x4*)(row + c0); }
#pragma unroll
    for (int t = 0; t < 8; ++t) { bf16_t* row = PM + (size_t)(tok_s + t) * PMP; float uu[8], g[8], o[8];
        unpack8(ru[t], uu); unpack8(rg[t], g);
#pragma unroll
        for (int e = 0; e < 8; ++e) { const float y = bb[e] + w0[e] * um2[e] + w1[e] * um1[e] + w2[e] * uu[e]; o[e] = g[e] * y; um2[e] = um1[e]; um1[e] = uu[e]; }
        *(u32x4*)(dmy ? dmy + (size_t)(tok_s + t) * 512 + c0 : row + c0) = pack8(o); }
}

DI void mixer_phase(const Params& p, LAS unsigned char* lds, int l, bf16_t* dmy) {
    bf16_t* PM = (bf16_t*)(p.ws + WS_BIG);
    const int G = gridDim.x;
    const bool rev = ((blockIdx.x >> 3) & 1) != 0;
    for (int st = 0; st < 4; ++st) {
        const int w0_ = rev ? 3 - st : st; const int which = (w0_ == 1) ? 2 : (w0_ == 2 ? 1 : w0_);
        if (which == 0) { for (int u = blockIdx.x; u < 512; u += G) attn_unit(lds, PM, p.qg + l * 64, p.kg + l * 64, u >> 8, (u >> 5) & 7, 31 - (u & 31), dmy); }
        else if (which == 1) { for (int u = blockIdx.x; u < 512; u += G) sgu_unit(lds, PM, (const bf16_t*)(p.ws + (size_t)l * WS_WL + W_SG), p.ln_g + l * 512, p.ln_b + l * 512, p.sgu_b + l * 512, u >> 2, u & 3, dmy); }
        else if (which == 2) { for (int u = blockIdx.x; u < 256; u += G) conv_unit(PM, p.conv_w + l * 1536, p.conv_b + l * 512, u, dmy); }
        else if (!dmy) {
            __syncthreads(); if (l == 0) convert_items(p, lds, I_MAIN, 2 * I_IN - I_MAIN + I_REST); else convert_items(p, lds, 2 * I_IN + I_REST, I_REST);
            asm volatile("s_waitcnt lgkmcnt(0)" ::: "memory"); __syncthreads(); }
    }
}


#define XB_TMO      128
#define XB_XCNT(j)  (256  + 64 * (j))
#define XB_XSUB(j)  (1280 + 64 * (j))
#define XB_XGEN(j)  (2304 + 64 * (j))
#define XB_TOP      3328
#define XB_TOPGEN   3392
#define XCD_BAR_WORDS 3456
#define XB_SPIN_CAP (1u << 22)
DI unsigned xb_ld(unsigned* p)              { return __hip_atomic_load(p, __ATOMIC_RELAXED, __HIP_MEMORY_SCOPE_AGENT); }
DI unsigned xb_add(unsigned* p, unsigned v) { return __hip_atomic_fetch_add(p, v, __ATOMIC_RELAXED, __HIP_MEMORY_SCOPE_AGENT); }
DI unsigned xb_xcc_id() { return (unsigned)__builtin_amdgcn_s_getreg((3 << 11) | 20) & 0xFu; }
#define XB_SPIN(cond, bar) do { unsigned _sp = 0; while (cond) { __builtin_amdgcn_s_sleep(1); \
    if ((++_sp & 255u) == 0u) { if (xb_ld(&(bar)[XB_TMO])) break; if (_sp > XB_SPIN_CAP) { atomicAdd(&(bar)[XB_TMO], 1u); break; } } } } while (0)
struct XcdBarrier { unsigned* bar; unsigned x; volatile LAS unsigned* st; };
DI XcdBarrier xcd_barrier_post(unsigned* bar, volatile LAS unsigned* st) {
    XcdBarrier b; b.bar = bar; b.x = xb_xcc_id(); b.st = st;
    if (threadIdx.x == 0) (void)xb_add(&bar[XB_XCNT(b.x)], 1u);
    return b;
}
DI void xcd_barrier_complete(unsigned* bar, unsigned x, unsigned& nloc, unsigned& nx) {
    const unsigned G = gridDim.x * gridDim.y * gridDim.z;
    unsigned sum, cnt, mine, sp = 0u;
    for (;;) {
        sum = 0u; cnt = 0u; mine = 0u;
#pragma unroll
        for (unsigned j = 0; j < 16; ++j) { const unsigned c = xb_ld(&bar[XB_XCNT(j)]); sum += c; cnt += (c > 0u) ? 1u : 0u; mine = (j == x) ? c : mine; }
        if (sum == G) break;
        __builtin_amdgcn_s_sleep(1);
        if ((++sp & 255u) == 0u) { if (xb_ld(&bar[XB_TMO])) break; if (sp > XB_SPIN_CAP) { atomicAdd(&bar[XB_TMO], 1u); break; } }
    }
    nloc = mine > 0u ? mine : 1u; nx = cnt > 0u ? cnt : 1u;
}
DI void xcd_barrier(const XcdBarrier& b) {
    asm volatile("s_waitcnt vmcnt(0)" ::: "memory");
    __syncthreads();
    if (threadIdx.x == 0) {
        unsigned* bar = b.bar;
        __builtin_amdgcn_s_waitcnt(0);
        unsigned nloc = b.st[0], nx = b.st[1];
        if (nloc == 0u) { xcd_barrier_complete(bar, b.x, nloc, nx); b.st[0] = nloc; b.st[1] = nx; }
        const unsigned old = xb_add(&bar[XB_XSUB(b.x)], 1u);
        const unsigned gen = old / nloc;
        if (old + 1u == (gen + 1u) * nloc) {
            __builtin_amdgcn_fence(__ATOMIC_RELEASE, "agent");
            asm volatile("s_waitcnt vmcnt(0)" ::: "memory");
            const unsigned og = xb_add(&bar[XB_TOP], 1u);
            const unsigned tg = og / nx;
            if (og + 1u == (tg + 1u) * nx) xb_add(&bar[XB_TOPGEN], 1u);
            else XB_SPIN(xb_ld(&bar[XB_TOPGEN]) == tg, bar);
            __builtin_amdgcn_fence(__ATOMIC_ACQUIRE, "agent");
            xb_add(&bar[XB_XGEN(b.x)], 1u);
            asm volatile("s_waitcnt vmcnt(0)" ::: "memory");
        } else {
            XB_SPIN(xb_ld(&bar[XB_XGEN(b.x)]) == gen, bar);
            __builtin_amdgcn_fence(__ATOMIC_ACQUIRE, "agent");
            asm volatile("s_waitcnt vmcnt(0)" ::: "memory");
        }
    }
    __syncthreads();
}

DI void panel_barrier(unsigned* cnt, unsigned target, bool same_xcd) {
    asm volatile("s_waitcnt vmcnt(0)" ::: "memory");
    __syncthreads();
    if (threadIdx.x == 0) {
        if (!same_xcd) { __builtin_amdgcn_fence(__ATOMIC_RELEASE, "agent"); asm volatile("s_waitcnt vmcnt(0)" ::: "memory"); }
        (void)xb_add(cnt, 1u);
        unsigned sp = 0;
        while (xb_ld(cnt) < target) { __builtin_amdgcn_s_sleep(1); if (++sp > (1u << 24)) break; }
        __builtin_amdgcn_fence(__ATOMIC_ACQUIRE, "agent"); asm volatile("s_waitcnt vmcnt(0)" ::: "memory");
    }
    __syncthreads();
}

__global__ void __launch_bounds__(512, 2) fwd_kernel(Params p) {
    extern __shared__ __attribute__((aligned(16))) unsigned char lds_raw[];
    LAS unsigned char* lds = (LAS unsigned char*)lds_raw;
    cg::grid_group grid = cg::this_grid();
    const int G = gridDim.x, c = blockIdx.x;
    bf16_t* PM = (bf16_t*)(p.ws + WS_BIG); bf16_t* XB = (bf16_t*)(p.ws + WS_XB); float* part = (float*)(p.ws + WS_PART); float* rsv = (float*)(p.ws + WS_RSV);
    volatile LAS unsigned* MISC = (volatile LAS unsigned*)(lds + 134144);
    if (threadIdx.x < 2) MISC[threadIdx.x] = 0u;
    __syncthreads();
    const XcdBarrier xbar = xcd_barrier_post((unsigned*)(p.ws + WS_BAR), MISC);
    unsigned* pcnt = (unsigned*)(p.ws + WS_BAR + 16384) + 64 * (8 * (c % 8) + ((c >> 3) & 7)); int npanel = 0;
    unsigned* xccs = (unsigned*)(p.ws + WS_XCC); bool same_xcd = false;
    if (threadIdx.x == 0) __hip_atomic_store(xccs + c, xbar.x + 1u, __ATOMIC_RELAXED, __HIP_MEMORY_SCOPE_AGENT);
    if (p.ph_hi > 1000) grid.sync();
    for (int ph = p.ph_lo; ph < p.ph_hi; ++ph) {
#ifndef PHMASK
#define PHMASK 127
#endif
#ifndef DUP_PH
#define DUP_PH -1
#endif
        const int reps = (ph == DUP_PH) ? 2 : 1;
        for (int rep = 0; rep < reps; ++rep) {
        bf16_t* dmy = (reps == 2 && rep == 0) ? (bf16_t*)(p.ws + WS_DMY) : nullptr;
        if (ph == 0) {
            if (G == 256) {
                phase0(p, lds, 0, 0);
                xcd_barrier(xbar);
                { const int c0 = c & 63; unsigned ok = 1u;
#pragma unroll
                    for (int j = 0; j < 4; ++j) ok &= (xb_ld(xccs + c0 + 64 * j) == xbar.x + 1u) ? 1u : 0u;
                    same_xcd = ok != 0u; }
                phase0(p, lds, 2, (8 * (c % 8) + ((c >> 3) & 7)) * 256 + (c >> 6) * 64);
            } else phase0(p, lds, 1, 0);
        }
        else {
            const int l = (ph - 1) / 6, k = (ph - 1) % 6; const unsigned char* wl = p.ws + (size_t)l * WS_WL;
            if (k == 0 && (PHMASK & 2)) {
                pg8::SchedPlain S; S.o.init(T_, NMAIN, G, c); S.A = (const char*)XB; S.B = (const char*)(wl + W_IN); S.lda2 = 2048; S.ldb2 = 2048; S.nt = 16; S.astride = 256 * 2048;
                pg8::EpiMain E{PM, part, rsv}; pg8::gemm_phase(lds, S, E);
            } else if (k == 1 && (PHMASK & 4)) {
                mixer_phase(p, lds, l, dmy);
            } else if (k == 2 && (PHMASK & 8)) {
                pg8::SchedBO S; S.o.init(T_, D_, G, c); S.XB = (const char*)XB; S.PM = (const char*)PM; S.WgT = (const char*)(wl + W_IN) + (size_t)NMAIN * 2048; S.WboT = (const char*)(wl + W_BO);
                pg8::EpiBO E{PM, rsv, p.b_gate + l * 3072}; pg8::gemm_phase(lds, S, E);
            } else if ((k == 3 || k == 5) && (PHMASK & 16)) {
                pg8::SchedPlain S; S.o.init(T_, D_, G, c);
                if (k == 3) { S.A = (const char*)(PM + COL_MG); S.B = (const char*)(wl + W_O); S.lda2 = PMP * 2; S.ldb2 = 2048; S.nt = 16; S.astride = (size_t)256 * PMP * 2; }
                else { S.A = (const char*)PM; S.B = (const char*)(wl + W_DN); S.lda2 = DFF * 2; S.ldb2 = DFF * 2; S.nt = DFF / 64; S.astride = (size_t)256 * PMP * 2; }
                pg8::EpiRes E{(k == 5 && l == 1) ? p.out : nullptr, XB, part}; pg8::gemm_phase(lds, S, E);
            } else if (k == 4 && (PHMASK & 32)) {
                if ((NGU / 256 * 64 - c + G - 1) / G < (NGU / 256 * 64 + G - 1) / G) { for (int i = 0; i < 3; ++i) __builtin_amdgcn_s_sleep(127); }
                pg8::SchedPlain S; S.o.init(T_, NGU, G, c); S.A = (const char*)XB; S.B = (const char*)(wl + W_GU); S.lda2 = 2048; S.ldb2 = 2048; S.nt = 16; S.astride = 256 * 2048;
                pg8::EpiGU E{PM, part}; pg8::gemm_phase(lds, S, E);
            }
        }
        if (rep + 1 < reps) __syncthreads();
        }
        if (ph + 1 < p.ph_hi) {
            const int kk = (ph == 0) ? -1 : (ph - 1) % 6;
            if (G == 256 && (kk >= 2 || ph == 0)) { ++npanel; panel_barrier(pcnt, 4u * (unsigned)npanel, same_xcd); }
            else { xcd_barrier(xbar);
                if (ph == 0 && G == 256) { const int c0 = c & 63; unsigned ok = 1u;
#pragma unroll
                    for (int j = 0; j < 4; ++j) ok &= (xb_ld(xccs + c0 + 64 * j) == xbar.x + 1u) ? 1u : 0u;
                    same_xcd = ok != 0u; } }
        }
    }
}

#ifndef N_LAUNCH_SPLIT
#define N_LAUNCH_SPLIT 0
#endif
extern "C" void kernel_launch(void* const* d_in, const int* in_sizes, int n_in, void* d_out, int out_size, void* d_ws, size_t ws_size, hipStream_t stream) {
    static int grid = 0;
    if (grid == 0) {
        if (n_in != 17 || out_size != T_ * D_ || ws_size < WS_END + 262144) { fprintf(stderr, "kernel_launch: unexpected shapes (n_in %d out %d ws %zu)\n", n_in, out_size, ws_size); grid = -1; return; }
        int dev = 0, cus = 0, per_cu = 0;
        hipGetDevice(&dev); hipDeviceGetAttribute(&cus, hipDeviceAttributeMultiprocessorCount, dev);
        hipFuncSetAttribute((const void*)fwd_kernel, hipFuncAttributeMaxDynamicSharedMemorySize, LDS_BYTES);
        hipOccupancyMaxActiveBlocksPerMultiprocessor(&per_cu, (const void*)fwd_kernel, 512, LDS_BYTES);
        if (per_cu < 1) { fprintf(stderr, "kernel_launch: occupancy query says %d blocks/CU\n", per_cu); per_cu = 1; }
        (void)hipGetLastError();
        grid = cus * 1;
    }
    if (grid < 0) return;
    Params p{};
    p.x = (const float*)d_in[0]; p.mix_g = (const float*)d_in[1]; p.w_in = (const float*)d_in[2]; p.b_gate = (const float*)d_in[3]; p.conv_w = (const float*)d_in[4]; p.conv_b = (const float*)d_in[5];
    p.ln_g = (const float*)d_in[6]; p.ln_b = (const float*)d_in[7]; p.sgu_w = (const float*)d_in[8]; p.sgu_b = (const float*)d_in[9]; p.qg = (const float*)d_in[10]; p.kg = (const float*)d_in[11];
    p.w_bo = (const float*)d_in[12]; p.w_o = (const float*)d_in[13]; p.ffn_g = (const float*)d_in[14]; p.w_gu = (const float*)d_in[15]; p.w_dn = (const float*)d_in[16];
    p.out = (float*)d_out; p.ws = (unsigned char*)d_ws;
#if N_LAUNCH_SPLIT
    for (int ph = 0; ph < 13; ++ph) { p.ph_lo = ph; p.ph_hi = ph + 1; hipLaunchKernelGGL(fwd_kernel, dim3(grid), dim3(512), LDS_BYTES, stream, p); }
#else
    p.ph_lo = 0; p.ph_hi = 13;
    (void)hipMemsetAsync((char*)d_ws + WS_BAR, 0, 32768, stream);
    void* args[] = {&p};
    hipError_t e = hipLaunchCooperativeKernel((const void*)fwd_kernel, dim3(grid), dim3(512), args, LDS_BYTES, stream);
    if (e != hipSuccess) fprintf(stderr, "cooperative launch failed: %s (grid %d)\n", hipGetErrorString(e), grid);
#endif
}
```

```cpp
#include <hip/hip_runtime.h>
#include <hip/hip_cooperative_groups.h>
#include <cstdio>
#include <cstdint>
#include <cmath>
namespace cg = cooperative_groups;

#define LAS __attribute__((address_space(3)))
#define DI __device__ __forceinline__
typedef unsigned short bf16_t;
typedef short bf16x8 __attribute__((ext_vector_type(8)));
typedef float f32x4 __attribute__((ext_vector_type(4)));
typedef float f32x2 __attribute__((ext_vector_type(2)));
typedef float f32x16 __attribute__((ext_vector_type(16)));
typedef unsigned u32x4 __attribute__((ext_vector_type(4)));
typedef unsigned u32x2 __attribute__((ext_vector_type(2)));
typedef short s16x4 __attribute__((ext_vector_type(4)));

constexpr int T_ = 16384, D_ = 1024, SEQ_ = 8192, NMAIN = 4096, NIN = 7168, DFF = 2816, NGU = 5632;
constexpr int PMP = 4096 + 64;
constexpr int COL_GS = 512, COL_MG = 3072;
constexpr float EPS = 1e-6f;
constexpr float C2 = 0.125f * 1.4426950408889634f;
constexpr float THR2 = -150.0f;

constexpr size_t MiB = 1u << 20;
constexpr size_t WS_WL = 36 * MiB;
constexpr size_t W_IN = 0, W_BO = 14 * MiB, W_O = 17 * MiB, W_GU = 19 * MiB, W_DN = 30 * MiB, W_SG = 35 * MiB + 512 * 1024;
constexpr size_t WS_PART = 72 * MiB, WS_XB = 73 * MiB, WS_BIG = 105 * MiB, WS_END = 236 * MiB, WS_BAR = 236 * MiB, WS_RSV = 236 * MiB + 64 * 1024, WS_DMY = 237 * MiB, WS_XCC = 236 * MiB + 192 * 1024;

constexpr int LDS_BYTES = 135168;

typedef __bf16 bf16x2_t __attribute__((ext_vector_type(2)));
DI unsigned cvt_pk_bf16(float lo, float hi) { f32x2 v = {lo, hi}; bf16x2_t b = __builtin_convertvector(v, bf16x2_t); return __builtin_bit_cast(unsigned, b); }
DI float bf_lo(unsigned w) { return __uint_as_float(w << 16); }
DI float bf_hi(unsigned w) { return __uint_as_float(w & 0xffff0000u); }
DI float bf2f(bf16_t v) { return __uint_as_float(((unsigned)v) << 16); }
DI bf16_t f2bf(float f) { return (bf16_t)(cvt_pk_bf16(f, 0.f) & 0xffffu); }
DI void unpack8(const u32x4 w, float* f) { f[0] = bf_lo(w.x); f[1] = bf_hi(w.x); f[2] = bf_lo(w.y); f[3] = bf_hi(w.y); f[4] = bf_lo(w.z); f[5] = bf_hi(w.z); f[6] = bf_lo(w.w); f[7] = bf_hi(w.w); }
DI u32x4 pack8(const float* f) { u32x4 w; w.x = cvt_pk_bf16(f[0], f[1]); w.y = cvt_pk_bf16(f[2], f[3]); w.z = cvt_pk_bf16(f[4], f[5]); w.w = cvt_pk_bf16(f[6], f[7]); return w; }
DI float wave_sum(float v) {
#pragma unroll
    for (int o = 1; o < 64; o <<= 1) v += __shfl_xor(v, o);
    return v;
}
DI float sigmoidf_(float x) { return __builtin_amdgcn_rcpf(1.0f + __builtin_amdgcn_exp2f(-1.4426950408889634f * x)); }
DI f32x2 gelu_pk(f32x2 v) {
    const f32x2 av = __builtin_elementwise_abs(v), d = av * 0.2316418882f + 1.0f;
    f32x2 t; t.x = __builtin_amdgcn_rcpf(d.x); t.y = __builtin_amdgcn_rcpf(d.y);
    f32x2 q = t * 0.5307027145f + (-0.7265760135f); q = q * t + 0.7107068705f; q = q * t + (-0.142248368f); q = q * t + 0.127414796f; q = q * t;
    const f32x2 s = (v * v) * (-0.72134752044f);
    f32x2 e; e.x = __builtin_amdgcn_exp2f(s.x); e.y = __builtin_amdgcn_exp2f(s.y);
    const f32x2 m = v * (q * e), r = v - m;
    f32x2 o; o.x = v.x < 0.f ? m.x : r.x; o.y = v.y < 0.f ? m.y : r.y; return o;
}
DI f32x4 gelu4(f32x4 v) { f32x2 a = gelu_pk((f32x2){v[0], v[1]}), b = gelu_pk((f32x2){v[2], v[3]}); return (f32x4){a.x, a.y, b.x, b.y}; }

namespace pg8 {
constexpr int BM = 256, BK = 64, HALF = 128, HTB = HALF * BK * 2, STAGE_BYTES = 8 * HTB, NXCD = 8, WGM = 8;
DI int lds_byte(int r, int c) { const int st = (r >> 4) * 2 + (c >> 5), rr = r & 15, cc = c & 31, ob = rr * 64 + cc * 2; return st * 1024 + (ob ^ (((ob >> 9) & 1) << 5)); }
DI void stage_rc(int b, int& R, int& C) { const int st = b / 1024, sb = b % 1024, swz = sb ^ (((sb >> 9) & 1) << 5); R = (st >> 1) * 16 + swz / 64; C = (st & 1) * 32 + (swz % 64) / 2; }
DI int perm32(int rho) { const int n = rho >> 4, i = rho & 15; return 8 * (i >> 2) + 4 * n + (i & 3); }

struct UnitD { const char* A; const char* B; unsigned lda2, ldb2; int nt; int pm, pn, aux; };

struct TileOrder {
    int nM, nN, nwg, G, c;
    DI void init(int M, int N, int G_, int c_) { nM = M / BM; nN = N / BM; nwg = nM * nN; G = G_; c = c_; }
    DI bool tile(int i, int& pm, int& pn) const {
        const long L = (long)i * G + c; if (L >= nwg) return false;
        int wgid = (int)L; { const int q = nwg / NXCD, r = nwg % NXCD, xcd = wgid % NXCD, off = wgid / NXCD; wgid = (xcd < r ? xcd * (q + 1) : r * (q + 1) + (xcd - r) * q) + off; }
        const int nig = WGM * nN, gid = wgid / nig, fm = gid * WGM, gsz = (nM - fm) < WGM ? (nM - fm) : WGM;
        pm = fm + ((wgid % nig) % gsz); pn = (wgid % nig) / gsz; return true;
    }
};
struct SchedPlain {
    static constexpr bool UNIFORM_LD = true;
    TileOrder o; const char* A; const char* B; unsigned lda2, ldb2; int nt; size_t astride; int rev_n = 0;
    DI bool get(int i, UnitD& u) const { int pm, pn; if (rev_n > 0) { if (i >= rev_n) return false; i = rev_n - 1 - i; } if (!o.tile(i, pm, pn)) return false; u.pm = pm; u.pn = pn; u.aux = 0;
        u.A = A + (size_t)pm * astride; u.B = B + (size_t)pn * BM * ldb2; u.lda2 = lda2; u.ldb2 = ldb2; u.nt = nt; return true; }
};
struct SchedBO {
    static constexpr bool UNIFORM_LD = false;
    TileOrder o; const char* XB; const char* PM; const char* WgT; const char* WboT;
    DI bool get(int i, UnitD& u) const { const int ti = i / 6, sub = i - ti * 6, br = sub >> 1; int pm, pn; if (!o.tile(ti, pm, pn)) return false; u.pm = pm; u.pn = pn; u.aux = sub;
        if ((sub & 1) == 0) { u.A = XB + (size_t)pm * BM * 2048; u.lda2 = 2048; u.B = WgT + (size_t)(br * 1024 + pn * BM) * 2048; u.ldb2 = 2048; u.nt = 16; }
        else { const int yc = br == 0 ? 0 : (br == 1 ? 1536 : 2560); u.A = PM + (size_t)pm * BM * (PMP * 2) + yc * 2; u.lda2 = PMP * 2; u.B = WboT + (size_t)(br * 1024 + pn * BM) * 1024; u.ldb2 = 1024; u.nt = 8; }
        return true; }
};

DI void row_rs8(const float* part, int row0, int fq, float (&rs)[2][4]) {
    f32x4 v[2][4];
#pragma unroll
    for (int ai = 0; ai < 2; ++ai)
#pragma unroll
        for (int m = 0; m < 4; ++m) v[ai][m] = *((const f32x4*)(part + (size_t)(row0 + ai * HALF + m * 16) * 16) + fq);
#pragma unroll
    for (int ai = 0; ai < 2; ++ai)
#pragma unroll
        for (int m = 0; m < 4; ++m) { float s_ = (v[ai][m][0] + v[ai][m][1]) + (v[ai][m][2] + v[ai][m][3]); s_ += __shfl_xor(s_, 16); s_ += __shfl_xor(s_, 32); rs[ai][m] = 1.0f / sqrtf(s_ * (1.0f / 1024.0f) + EPS); }
}
template <class Epi, class Sched>
DI void gemm_phase(LAS unsigned char* lds, const Sched& S, const Epi& E) {
    int tid_ = threadIdx.x; asm volatile("" : "+v"(tid_)); const int tid = tid_, wid = __builtin_amdgcn_readfirstlane(tid >> 6), lane = tid & 63, wr = wid >> 2, wc = wid & 3, fr = lane & 15, fq = lane >> 4;
#define PG8_VOFFS(lda_, ldb_, oA0, oA1, oB0, oB1) do { int t2_ = tid; asm volatile("" : "+v"(t2_)); int R0_, C0_, R1_, C1_; stage_rc(t2_ * 16, R0_, C0_); stage_rc(t2_ * 16 + 8192, R1_, C1_); \
        const int Rb0_ = (R0_ & ~31) + perm32(R0_ & 31), Rb1_ = (R1_ & ~31) + perm32(R1_ & 31); \
        oA0 = (unsigned)R0_ * (lda_) + C0_ * 2; oA1 = (unsigned)R1_ * (lda_) + C1_ * 2; oB0 = (unsigned)Rb0_ * (ldb_) + C0_ * 2; oB1 = (unsigned)Rb1_ * (ldb_) + C1_ * 2; } while (0)
    const size_t kstep = (size_t)(BK * 2);
    const unsigned ldsw = (unsigned)wid * 1024u;
    const int aoff = lds_byte(wr * 64 + fr, fq * 8), boff = lds_byte(wc * 32 + fr, fq * 8);
#define PG8_SA(b, h) (((b) * 2 + (h)) * HTB)
#define PG8_SB(b, h) ((4 + (b) * 2 + (h)) * HTB)
#define PG8_STAGE(bufoff, gbase, v0, v1) do { \
        __builtin_amdgcn_global_load_lds((const unsigned*)((const char*)(gbase) + (v0)), (LAS unsigned*)(lds + (bufoff) + ldsw), 16, 0, 0); \
        __builtin_amdgcn_global_load_lds((const unsigned*)((const char*)(gbase) + (v1)), (LAS unsigned*)(lds + (bufoff) + ldsw + 8192), 16, 0, 0); } while (0)
#define PG8_LDA(dst, b, h) do { _Pragma("unroll") for (int m = 0; m < 4; ++m) _Pragma("unroll") for (int k = 0; k < 2; ++k) dst[m][k] = *(const LAS bf16x8*)(lds + PG8_SA(b, h) + aoff + m * 2048 + k * 1024); } while (0)
#define PG8_LDB(dst, b, h) do { _Pragma("unroll") for (int n = 0; n < 2; ++n) _Pragma("unroll") for (int k = 0; k < 2; ++k) dst[n][k] = *(const LAS bf16x8*)(lds + PG8_SB(b, h) + boff + n * 2048 + k * 1024); } while (0)
#define PG8_MMA(ai, bj, At, Bt) do { __builtin_amdgcn_s_setprio(1); _Pragma("unroll") for (int m = 0; m < 4; ++m) _Pragma("unroll") for (int n = 0; n < 2; ++n) _Pragma("unroll") for (int k = 0; k < 2; ++k) \
        acc[ai][bj][m][n] = __builtin_amdgcn_mfma_f32_16x16x32_bf16(Bt[n][k], At[m][k], acc[ai][bj][m][n], 0, 0, 0); __builtin_amdgcn_s_setprio(0); } while (0)
#define PG8_WAIT_V(n) asm volatile("s_waitcnt vmcnt(" #n ")" ::: "memory")
#define PG8_WAIT_L(n) asm volatile("s_waitcnt lgkmcnt(" #n ")" ::: "memory")
#define PG8_BAR __builtin_amdgcn_s_barrier()
#define PG8_SCHED __builtin_amdgcn_sched_barrier(0)
    UnitD cur, nxt; int ui = 0;
    if (!S.get(0, cur)) return;
    float rsc[2][4]; int rs_pm = cur.pm;
    if constexpr (Epi::NEEDS_RS) row_rs8(E.part, cur.pm * BM + wr * 64 + fr, fq, rsc);
    f32x4 acc[2][2][4][2];
#pragma unroll
    for (int a = 0; a < 2; ++a)
#pragma unroll
        for (int b = 0; b < 2; ++b)
#pragma unroll
            for (int m = 0; m < 4; ++m)
#pragma unroll
                for (int n = 0; n < 2; ++n) acc[a][b][m][n] = (f32x4){0.f, 0.f, 0.f, 0.f};
    bf16x8 At[4][2], B0[2][2], B1[2][2];
    const char* cA = cur.A; const char* cB = cur.B;
    unsigned vA0, vA1, vB0, vB1; PG8_VOFFS(cur.lda2, cur.ldb2, vA0, vA1, vB0, vB1);
    size_t hA = (size_t)HALF * cur.lda2, hB = (size_t)HALF * cur.ldb2;
    PG8_STAGE(PG8_SB(0, 0), cB, vB0, vB1); PG8_STAGE(PG8_SB(0, 1), cB + hB, vB0, vB1); PG8_STAGE(PG8_SA(0, 0), cA, vA0, vA1); PG8_STAGE(PG8_SA(0, 1), cA + hA, vA0, vA1);
    if (wr == 1) PG8_BAR;
    PG8_WAIT_V(2); PG8_BAR;
    PG8_STAGE(PG8_SB(1, 0), cB + kstep, vB0, vB1); PG8_STAGE(PG8_SA(1, 0), cA + kstep, vA0, vA1); PG8_STAGE(PG8_SB(1, 1), cB + hB + kstep, vB0, vB1);
    PG8_WAIT_V(6); PG8_BAR;
    for (;;) {
        const bool has_next = S.get(ui + 1, nxt);
        const char* nA = has_next ? nxt.A : cA; const char* nB = has_next ? nxt.B : cB;
        unsigned nvA0 = vA0, nvA1 = vA1, nvB0 = vB0, nvB1 = vB1; size_t nhA = hA, nhB = hB;
        if constexpr (!Sched::UNIFORM_LD) {
            const unsigned nlda = has_next ? nxt.lda2 : cur.lda2, nldb = has_next ? nxt.ldb2 : cur.ldb2;
            PG8_VOFFS(nlda, nldb, nvA0, nvA1, nvB0, nvB1); nhA = (size_t)HALF * nlda; nhB = (size_t)HALF * nldb;
        }
        const int nt = cur.nt;
        for (int t = 0; t < nt; t += 2) {
            const bool last = (t == nt - 2);
            const char* a1 = cA + (size_t)(t + 1) * kstep;
            const char* a2 = last ? nA : cA + (size_t)(t + 2) * kstep; const char* b2 = last ? nB : cB + (size_t)(t + 2) * kstep;
            const char* a3 = a2 + kstep; const char* b3 = b2 + kstep;
            const unsigned xA0 = last ? nvA0 : vA0, xA1 = last ? nvA1 : vA1, xB0 = last ? nvB0 : vB0, xB1 = last ? nvB1 : vB1;
            const size_t xhA = last ? nhA : hA, xhB = last ? nhB : hB;
            PG8_LDB(B0, 0, 0); PG8_LDB(B1, 0, 1); PG8_SCHED; PG8_LDA(At, 0, 0); PG8_STAGE(PG8_SA(1, 1), a1 + hA, vA0, vA1);
            PG8_WAIT_V(8); PG8_WAIT_L(0); PG8_BAR; PG8_MMA(0, 0, At, B0); PG8_MMA(0, 1, At, B1); PG8_BAR; PG8_SCHED;
            PG8_LDA(At, 0, 1); PG8_STAGE(PG8_SB(0, 0), b2, xB0, xB1); PG8_STAGE(PG8_SB(0, 1), b2 + xhB, xB0, xB1); PG8_STAGE(PG8_SA(0, 0), a2, xA0, xA1);
            PG8_WAIT_V(8); PG8_WAIT_L(0); PG8_BAR; PG8_MMA(1, 0, At, B0); PG8_MMA(1, 1, At, B1); PG8_BAR; PG8_SCHED;
            PG8_LDB(B0, 1, 0); PG8_LDB(B1, 1, 1); PG8_SCHED; PG8_LDA(At, 1, 0); PG8_STAGE(PG8_SA(0, 1), a2 + xhA, xA0, xA1);
            PG8_WAIT_V(8); PG8_WAIT_L(0); PG8_BAR; PG8_MMA(0, 0, At, B0); PG8_MMA(0, 1, At, B1); PG8_BAR; PG8_SCHED;
            PG8_LDA(At, 1, 1); PG8_STAGE(PG8_SB(1, 0), b3, xB0, xB1); PG8_STAGE(PG8_SB(1, 1), b3 + xhB, xB0, xB1); PG8_STAGE(PG8_SA(1, 0), a3, xA0, xA1);
            PG8_WAIT_V(8); PG8_WAIT_L(0); PG8_BAR; PG8_MMA(1, 0, At, B0); PG8_MMA(1, 1, At, B1); PG8_BAR; PG8_SCHED;
        }
        if (wr == 0) PG8_BAR;
        if constexpr (Epi::NEEDS_RS) { if (cur.pm != rs_pm) { row_rs8(E.part, cur.pm * BM + wr * 64 + fr, fq, rsc); rs_pm = cur.pm; } E(acc, cur, wr, wc, fr, fq, rsc); }
        else E(acc, cur, wr, wc, fr, fq);
        if (!has_next) break;
#pragma unroll
        for (int a = 0; a < 2; ++a)
#pragma unroll
            for (int b = 0; b < 2; ++b)
#pragma unroll
                for (int m = 0; m < 4; ++m)
#pragma unroll
                    for (int n = 0; n < 2; ++n) acc[a][b][m][n] = (f32x4){0.f, 0.f, 0.f, 0.f};
        cur = nxt; cA = nA; cB = nB; ++ui; vA0 = nvA0; vA1 = nvA1; vB0 = nvB0; vB1 = nvB1; hA = nhA; hB = nhB;
        if (wr == 1) PG8_BAR;
    }
    PG8_WAIT_V(0);
    PG8_BAR;
#undef PG8_VOFFS
#undef PG8_SA
#undef PG8_SB
#undef PG8_STAGE
#undef PG8_LDA
#undef PG8_LDB
#undef PG8_MMA
#undef PG8_WAIT_V
#undef PG8_WAIT_L
#undef PG8_BAR
#undef PG8_SCHED
}

DI u32x4 pk8(const f32x4 v0, const f32x4 v1) { u32x4 w; w.x = cvt_pk_bf16(v0[0], v0[1]); w.y = cvt_pk_bf16(v0[2], v0[3]); w.z = cvt_pk_bf16(v1[0], v1[1]); w.w = cvt_pk_bf16(v1[2], v1[3]); return w; }

struct EpiMain {
    static constexpr bool NEEDS_RS = true;
    bf16_t* PM; const float* part; float* rsv;
    DI void operator()(const f32x4 (&acc)[2][2][4][2], const UnitD& u, int wr, int wc, int fr, int fq, const float (&rs)[2][4]) const {
        const int row0 = u.pm * BM + wr * 64 + fr, col0 = u.pn * BM + wc * 32 + 8 * fq; const bool gl = (u.pn >= 6 && u.pn < 10);
#pragma unroll
        for (int ai = 0; ai < 2; ++ai)
#pragma unroll
            for (int m = 0; m < 4; ++m) { const int row = row0 + ai * HALF + m * 16; const float r_ = rs[ai][m]; bf16_t* rowp = PM + (size_t)row * PMP + col0;
                if (u.pn == 0 && wc == 0 && fq == 0) rsv[row] = r_;
                if (u.pn >= 2 && u.pn < 6) {
                    float o[8];
#pragma unroll
                    for (int n = 0; n < 2; ++n) { const f32x4 cg = acc[ai][0][m][n] * r_, xa = acc[ai][1][m][n] * r_;
#pragma unroll
                        for (int e = 0; e < 4; ++e) o[4 * n + e] = cg[e] * xa[e]; }
                    *(u32x4*)(PM + (size_t)row * PMP + 512 + 128 * (u.pn - 2) + wc * 32 + 8 * fq) = pack8(o);
                } else {
#pragma unroll
                for (int bj = 0; bj < 2; ++bj) { f32x4 v0 = acc[ai][bj][m][0] * r_, v1 = acc[ai][bj][m][1] * r_; if (gl) { v0 = gelu4(v0); v1 = gelu4(v1); }
                    *(u32x4*)(rowp + bj * HALF) = pk8(v0, v1); } } }
    }
};
struct EpiBO {
    static constexpr bool NEEDS_RS = false;
    bf16_t* PM; const float* rsv; const float* bgate;
    DI void operator()(const f32x4 (&acc)[2][2][4][2], const UnitD& u, int wr, int wc, int fr, int fq) const {
        const int row0 = u.pm * BM + wr * 64 + fr, col0 = u.pn * BM + wc * 32 + 8 * fq, br = u.aux >> 1;
        if ((u.aux & 1) == 0) {
            f32x4 bv[2][2]; float rs[2][4];
#pragma unroll
            for (int bj = 0; bj < 2; ++bj)
#pragma unroll
                for (int n = 0; n < 2; ++n) bv[bj][n] = *(const f32x4*)(bgate + br * 1024 + col0 + bj * HALF + 4 * n);
#pragma unroll
            for (int ai = 0; ai < 2; ++ai)
#pragma unroll
                for (int m = 0; m < 4; ++m) rs[ai][m] = rsv[row0 + ai * HALF + m * 16];
#pragma unroll
            for (int ai = 0; ai < 2; ++ai)
#pragma unroll
                for (int m = 0; m < 4; ++m) { const int row = row0 + ai * HALF + m * 16; const float r_ = rs[ai][m];
#pragma unroll
                    for (int bj = 0; bj < 2; ++bj) { f32x4 v0 = acc[ai][bj][m][0] * r_ + bv[bj][0], v1 = acc[ai][bj][m][1] * r_ + bv[bj][1];
                        unsigned q0 = 0u, q1 = 0u;
#pragma unroll
                        for (int e = 0; e < 4; ++e) { q0 |= (unsigned)(sigmoidf_(v0[e]) * 255.0f + 0.5f) << (8 * e); q1 |= (unsigned)(sigmoidf_(v1[e]) * 255.0f + 0.5f) << (8 * e); }
                        *(u32x2*)((unsigned char*)(PM + (size_t)row * PMP + COL_GS) + col0 + bj * HALF) = (u32x2){q0, q1}; } }
        } else {
#pragma unroll
            for (int ai = 0; ai < 2; ++ai) {
                u32x2 gw[4][2]; u32x4 mw[4][2];
#pragma unroll
                for (int m = 0; m < 4; ++m)
#pragma unroll
                    for (int bj = 0; bj < 2; ++bj) { const size_t rr_ = (size_t)(row0 + ai * HALF + m * 16) * PMP, ro = rr_ + col0 + bj * HALF; gw[m][bj] = *(const u32x2*)((const unsigned char*)(PM + rr_ + COL_GS) + col0 + bj * HALF); mw[m][bj] = (br > 0) ? *(const u32x4*)(PM + ro + COL_MG) : (u32x4){0u, 0u, 0u, 0u}; }
#pragma unroll
                for (int m = 0; m < 4; ++m)
#pragma unroll
                    for (int bj = 0; bj < 2; ++bj) { float g[8], o[8], pv_[8]; unpack8(mw[m][bj], pv_);
#pragma unroll
                        for (int e = 0; e < 4; ++e) { g[e] = (float)((gw[m][bj].x >> (8 * e)) & 0xffu) * (1.0f / 255.0f); g[4 + e] = (float)((gw[m][bj].y >> (8 * e)) & 0xffu) * (1.0f / 255.0f); }
                        const f32x4 a0 = acc[ai][bj][m][0], a1 = acc[ai][bj][m][1];
#pragma unroll
                        for (int e = 0; e < 4; ++e) { o[e] = a0[e] * g[e] + pv_[e]; o[4 + e] = a1[e] * g[4 + e] + pv_[4 + e]; }
                        *(u32x4*)(PM + (size_t)(row0 + ai * HALF + m * 16) * PMP + col0 + bj * HALF + COL_MG) = pack8(o); }
                asm volatile("" ::: "memory");
            }
        }
    }
};
struct EpiRes {
    static constexpr bool NEEDS_RS = false;
    float* out; bf16_t* XB; float* part;
    DI void operator()(const f32x4 (&acc)[2][2][4][2], const UnitD& u, int wr, int wc, int fr, int fq) const {
        const int row0 = u.pm * BM + wr * 64 + fr, col0 = u.pn * BM + wc * 32 + 8 * fq;
        u32x4 xw[2][4][2];
#pragma unroll
        for (int ai = 0; ai < 2; ++ai)
#pragma unroll
            for (int m = 0; m < 4; ++m)
#pragma unroll
                for (int bj = 0; bj < 2; ++bj) xw[ai][m][bj] = *(const u32x4*)(XB + (size_t)(row0 + ai * HALF + m * 16) * D_ + col0 + bj * HALF);
#pragma unroll
        for (int ai = 0; ai < 2; ++ai)
#pragma unroll
            for (int m = 0; m < 4; ++m) { const int row = row0 + ai * HALF + m * 16; const size_t off = (size_t)row * D_ + col0; float ss = 0.f;
#pragma unroll
                for (int bj = 0; bj < 2; ++bj) { float b[8]; unpack8(xw[ai][m][bj], b);
                    const f32x4 a0 = acc[ai][bj][m][0], a1 = acc[ai][bj][m][1];
                    const f32x4 x0 = (f32x4){b[0] + a0[0], b[1] + a0[1], b[2] + a0[2], b[3] + a0[3]}, x1 = (f32x4){b[4] + a1[0], b[5] + a1[1], b[6] + a1[2], b[7] + a1[3]};
                    if (out) { *(f32x4*)(out + off + bj * HALF) = x0; *(f32x4*)(out + off + bj * HALF + 4) = x1; }
                    else { *(u32x4*)(XB + off + bj * HALF) = pk8(x0, x1);
                        ss += ((x0[0] * x0[0] + x0[1] * x0[1]) + (x0[2] * x0[2] + x0[3] * x0[3])) + ((x1[0] * x1[0] + x1[1] * x1[1]) + (x1[2] * x1[2] + x1[3] * x1[3])); } }
                if (!out) { ss += __shfl_xor(ss, 16); ss += __shfl_xor(ss, 32);
                    if (fq == 0) part[(size_t)row * 16 + u.pn * 4 + wc] = ss; } }
    }
};
struct EpiGU {
    static constexpr bool NEEDS_RS = true;
    bf16_t* ACT; const float* part;
    DI void operator()(const f32x4 (&acc)[2][2][4][2], const UnitD& u, int wr, int wc, int fr, int fq, const float (&rs)[2][4]) const {
        const int row0 = u.pm * BM + wr * 64 + fr, col0 = u.pn * HALF + wc * 32 + 8 * fq;
#pragma unroll
        for (int ai = 0; ai < 2; ++ai)
#pragma unroll
            for (int m = 0; m < 4; ++m) { const int row = row0 + ai * HALF + m * 16; const float r_ = rs[ai][m]; float o[8];
#pragma unroll
                for (int n = 0; n < 2; ++n) { const f32x4 g = acc[ai][0][m][n] * r_, uu = acc[ai][1][m][n] * r_;
#pragma unroll
                    for (int e = 0; e < 4; ++e) o[4 * n + e] = g[e] * sigmoidf_(g[e]) * uu[e]; }
                *(u32x4*)(ACT + (size_t)(row >> 8) * ((size_t)PMP * 256) + (size_t)(row & 255) * DFF + col0) = pack8(o); }
    }
};
}

DI void transpose_item(const float* W, int N, int Kd, const float* kscale, bf16_t* WT, int k0, int n0, int drow0, LAS float* scr, int lane) {
    const int kq = lane >> 4, nq = (lane & 15) * 4;
    f32x4 v[16];
#pragma unroll
    for (int i = 0; i < 16; ++i) v[i] = *(const f32x4*)(W + (size_t)(k0 + 4 * i + kq) * N + n0 + nq);
#pragma unroll
    for (int i = 0; i < 16; ++i) { const int kk = 4 * i + kq; const float sc = kscale ? kscale[k0 + kk] : 1.0f; LAS float* d = scr + kk * 65 + nq;
        d[0] = v[i][0] * sc; d[1] = v[i][1] * sc; d[2] = v[i][2] * sc; d[3] = v[i][3] * sc; }
    asm volatile("s_waitcnt lgkmcnt(0)" ::: "memory");
    const int c = lane & 7;
#pragma unroll
    for (int j = 0; j < 8; ++j) { const int n = (lane >> 3) + 8 * j; const LAS float* s_ = scr + (8 * c) * 65 + n;
        u32x4 o; o.x = cvt_pk_bf16(s_[0 * 65], s_[1 * 65]); o.y = cvt_pk_bf16(s_[2 * 65], s_[3 * 65]); o.z = cvt_pk_bf16(s_[4 * 65], s_[5 * 65]); o.w = cvt_pk_bf16(s_[6 * 65], s_[7 * 65]);
        *(u32x4*)(WT + (size_t)(drow0 + n) * Kd + k0 + 8 * c) = o; }
    asm volatile("s_waitcnt lgkmcnt(0)" ::: "memory");
}

struct Params {
    const float* x; const float* mix_g; const float* w_in; const float* b_gate; const float* conv_w; const float* conv_b;
    const float* ln_g; const float* ln_b; const float* sgu_w; const float* sgu_b; const float* qg; const float* kg;
    const float* w_bo; const float* w_o; const float* ffn_g; const float* w_gu; const float* w_dn;
    float* out; unsigned char* ws; int ph_lo, ph_hi;
};

constexpr int I_MAIN = 16 * 64, I_IN = 16 * 112, I_BO = 3 * 8 * 16, I_O = 16 * 16, I_GU = 16 * 88, I_DN = 44 * 16, I_REST = I_BO + I_O + I_GU + I_DN;
DI int win_row(int nb) { if (nb >= 8 && nb < 16) { const int cc = 64 * nb - 512; return 512 + 256 * (cc / 128) + (cc % 128); } if (nb >= 16 && nb < 24) { const int cc = 64 * nb - 1024; return 512 + 256 * (cc / 128) + 128 + (cc % 128); } return 64 * nb; }
DI void convert_items(const Params& p, LAS unsigned char* lds, int first, int count) {
    int tid_ = threadIdx.x; asm volatile("" : "+v"(tid_)); const int tid = tid_, lane = tid & 63, wave = tid >> 6;
    LAS float* scr = (LAS float*)(lds + wave * 16640);
    const int gw = blockIdx.x * 8 + wave, NGW = gridDim.x * 8;
    for (int it = first + gw; it < first + count; it += NGW) {
        if (it < 2 * I_IN) { int l, kb, nb;
            if (it < I_MAIN) { l = 0; kb = it / 64; nb = it % 64; }
            else if (it < I_IN) { const int r = it - I_MAIN; l = 0; kb = r / 48; nb = 64 + r % 48; }
            else { const int r = it - I_IN; l = 1; kb = r / 112; nb = r % 112; }
            unsigned char* wl = p.ws + (size_t)l * WS_WL;
            transpose_item(p.w_in + (size_t)l * D_ * NIN, NIN, 1024, p.mix_g + l * D_, (bf16_t*)(wl + W_IN), 64 * kb, 64 * nb, win_row(nb), scr, lane); continue; }
        const int q = it - 2 * I_IN, l = q / I_REST; int r = q - l * I_REST; unsigned char* wl = p.ws + (size_t)l * WS_WL;
        if (r < I_BO) { const int i = r / 128, rr = r % 128, kb = rr / 16, nb = rr % 16; transpose_item(p.w_bo + ((size_t)l * 3 + i) * 512 * 1024, 1024, 512, nullptr, (bf16_t*)(wl + W_BO) + (size_t)i * 1024 * 512, 64 * kb, 64 * nb, 64 * nb, scr, lane); continue; } r -= I_BO;
        if (r < I_O) { const int kb = r / 16, nb = r % 16; transpose_item(p.w_o + (size_t)l * 1024 * 1024, 1024, 1024, nullptr, (bf16_t*)(wl + W_O), 64 * kb, 64 * nb, 64 * nb, scr, lane); continue; } r -= I_O;
        if (r < I_GU) { const int kb = r / 88, nb = r % 88, n0 = 64 * nb, cc = n0 < DFF ? n0 : n0 - DFF, dr = 256 * (cc / 128) + (cc % 128) + (n0 < DFF ? 0 : 128);
            transpose_item(p.w_gu + (size_t)l * 1024 * NGU, NGU, 1024, p.ffn_g + l * D_, (bf16_t*)(wl + W_GU), 64 * kb, n0, dr, scr, lane); continue; } r -= I_GU;
        { const int kb = r / 16, nb = r % 16; transpose_item(p.w_dn + (size_t)l * DFF * 1024, 1024, DFF, nullptr, (bf16_t*)(wl + W_DN), 64 * kb, 64 * nb, 64 * nb, scr, lane); }
    }
}
DI void phase0(const Params& p, LAS unsigned char* lds, int mode, int row_base) {
    int tid_ = threadIdx.x; asm volatile("" : "+v"(tid_)); const int tid = tid_, lane = tid & 63, wave = tid >> 6;
    const int gw = blockIdx.x * 8 + wave, NGW = gridDim.x * 8;
    if (mode != 2) {
    convert_items(p, lds, 0, I_MAIN);
    for (int i = blockIdx.x * 512 + tid; i < 2 * 4 * 128 * 128; i += gridDim.x * 512) {
        const int l = i >> 16, rem = i & 65535, t = (rem >> 7) & 127, s = rem & 127; const float w = p.sgu_w[i];
        ((bf16_t*)(p.ws + (size_t)l * WS_WL + W_SG))[rem] = f2bf(s <= t ? w : 0.f);
    }
    }
    if (mode == 0) return;
    bf16_t* XB = (bf16_t*)(p.ws + WS_XB); float* part = (float*)(p.ws + WS_PART);
    const int mfirst = (mode == 2) ? row_base + wave * 8 : gw, mstep = (mode == 2) ? 1 : NGW, mend = (mode == 2) ? row_base + wave * 8 + 8 : T_;
    for (int m0 = mfirst; m0 < mend; m0 += 4 * mstep) {
        f32x4 v[4][4];
#pragma unroll
        for (int q = 0; q < 4; ++q) { const int m = m0 + q * mstep; const f32x4* xr = (const f32x4*)(p.x + (size_t)(m < mend ? m : m0) * D_) + lane;
#pragma unroll
            for (int j = 0; j < 4; ++j) v[q][j] = xr[64 * j]; }
#pragma unroll
        for (int q = 0; q < 4; ++q) { const int m = m0 + q * mstep; if (m < mend) { float ss = 0.f; u32x2* o8 = (u32x2*)(XB + (size_t)m * D_) + lane;
#pragma unroll
            for (int j = 0; j < 4; ++j) { const f32x4 w_ = v[q][j]; ss += (w_[0] * w_[0] + w_[1] * w_[1]) + (w_[2] * w_[2] + w_[3] * w_[3]); u32x2 w; w.x = cvt_pk_bf16(w_[0], w_[1]); w.y = cvt_pk_bf16(w_[2], w_[3]); o8[64 * j] = w; }
            ss = wave_sum(ss);
            if (lane < 16) part[(size_t)m * 16 + lane] = lane == 0 ? ss : 0.f; } }
    }
}

DI int crow(int r, int hi) { return (r & 3) + 8 * (r >> 2) + 4 * hi; }

constexpr int AT_K = 0, AT_V = 8192, AT_BUF = 16384, AT_FLAG = 32768, AT_OST = 32768 + 256;
DI void pv_acc(f32x16& o0, f32x16& o1, int vb, bf16x8 pa0, bf16x8 pa1, bf16x8 pa2, bf16x8 pa3) {
#pragma unroll
    for (int d0 = 0; d0 < 2; ++d0) { s16x4 lo[4], hi[4];
#pragma unroll
        for (int ks = 0; ks < 4; ++ks) {
            asm volatile("ds_read_b64_tr_b16 %0,%1 offset:%c2" : "=&v"(lo[ks]) : "v"(vb), "i"(d0 * 4096 + ks * 1024) : "memory");
            asm volatile("ds_read_b64_tr_b16 %0,%1 offset:%c2" : "=&v"(hi[ks]) : "v"(vb), "i"(d0 * 4096 + ks * 1024 + 512) : "memory"); }
        asm volatile("s_waitcnt lgkmcnt(0)" ::: "memory"); __builtin_amdgcn_sched_barrier(0);
#define PK(k) (bf16x8){lo[k][0], lo[k][1], lo[k][2], lo[k][3], hi[k][0], hi[k][1], hi[k][2], hi[k][3]}
        f32x16 o = d0 ? o1 : o0;
        o = __builtin_amdgcn_mfma_f32_32x32x16_bf16(pa0, PK(0), o, 0, 0, 0);
        o = __builtin_amdgcn_mfma_f32_32x32x16_bf16(pa1, PK(1), o, 0, 0, 0);
        o = __builtin_amdgcn_mfma_f32_32x32x16_bf16(pa2, PK(2), o, 0, 0, 0);
        o = __builtin_amdgcn_mfma_f32_32x32x16_bf16(pa3, PK(3), o, 0, 0, 0);
        if (d0) o1 = o; else o0 = o;
#undef PK
    }
}

DI void attn_unit(LAS unsigned char* lds, bf16_t* PM, const float* gq, const float* gk, int b, int h, int qb, bf16_t* dmy) {
    int tid_ = threadIdx.x; asm volatile("" : "+v"(tid_)); const int tid = tid_, lane = tid & 63, r32 = lane & 31, hi = lane >> 5, wid = __builtin_amdgcn_readfirstlane(tid >> 6);
    const int q0 = qb * 256; const size_t rowbase = (size_t)b * SEQ_;
    bf16x8 qr[4];
    {
        const bf16_t* Qp = PM + (rowbase + q0 + wid * 32 + r32) * PMP + 2560 + h * 64 + hi * 8;
        float qf[4][8]; float ss = 0.f;
#pragma unroll
        for (int d0 = 0; d0 < 4; ++d0) { unpack8(*(const u32x4*)(Qp + d0 * 16), qf[d0]);
#pragma unroll
            for (int e = 0; e < 8; ++e) ss += qf[d0][e] * qf[d0][e]; }
        ss += __shfl_xor(ss, 32);
        const float sc = C2 / sqrtf(ss * (1.0f / 64.0f) + EPS);
#pragma unroll
        for (int d0 = 0; d0 < 4; ++d0) { float t[8];
#pragma unroll
            for (int e = 0; e < 8; ++e) t[e] = qf[d0][e] * sc * gq[d0 * 16 + hi * 8 + e];
            qr[d0] = __builtin_bit_cast(bf16x8, pack8(t)); }
    }
    const int key = tid >> 3, ch = tid & 7;
    float gkv[8];
#pragma unroll
    for (int e = 0; e < 8; ++e) gkv[e] = gk[ch * 8 + e];
    const bf16_t* kvp = PM + (rowbase + key) * PMP + 3072 + h * 64 + ch * 8;
    LAS unsigned char* kdst = lds + AT_K + ch * 1024 + key * 16;
    LAS unsigned char* vdst = lds + AT_V + ((ch >> 2) * 4 + (key >> 4)) * 1024 + (key & 15) * 64 + (ch & 3) * 16;
    const LAS unsigned char* kb = lds + AT_K + hi * 1024 + r32 * 16;
    const int vb0 = (int)(unsigned)(uintptr_t)(lds + AT_V) + ((lane >> 4) & 1) * 32 + (lane & 3) * 8 + (4 * hi + ((lane & 15) >> 2)) * 64;
    volatile LAS unsigned* flags = (volatile LAS unsigned*)(lds + AT_FLAG);
    const int NT = (q0 + 256) / 64, wq0 = q0 + wid * 32, qi = wq0 + r32;
    float carry = 0.f; f32x16 o0, o1;
#pragma unroll
    for (int r = 0; r < 16; ++r) { o0[r] = 0.f; o1[r] = 0.f; }
    bool wdone = false;
#define AT_STAGE(kr, vr, bsel) do { float kf[8]; unpack8(kr, kf); float ss_ = 0.f; \
        _Pragma("unroll") for (int e = 0; e < 8; ++e) ss_ += kf[e] * kf[e]; \
        ss_ += __shfl_xor(ss_, 1); ss_ += __shfl_xor(ss_, 2); ss_ += __shfl_xor(ss_, 4); \
        const float sc_ = 1.0f / sqrtf(ss_ * (1.0f / 64.0f) + EPS); \
        _Pragma("unroll") for (int e = 0; e < 8; ++e) kf[e] = kf[e] * sc_ * gkv[e]; \
        *(LAS u32x4*)(kdst + (bsel) * AT_BUF) = pack8(kf); *(LAS u32x4*)(vdst + (bsel) * AT_BUF) = vr; } while (0)
    u32x4 kraw = *(const u32x4*)(kvp + (size_t)(NT - 1) * 64 * PMP), vraw = *(const u32x4*)(kvp + (size_t)(NT - 1) * 64 * PMP + 512);
    __syncthreads();
    AT_STAGE(kraw, vraw, (NT - 1) & 1);
    if (NT > 1) { kraw = *(const u32x4*)(kvp + (size_t)(NT - 2) * 64 * PMP); vraw = *(const u32x4*)(kvp + (size_t)(NT - 2) * 64 * PMP + 512); }
    for (int jt = NT - 1; jt >= 0; --jt) {
        __syncthreads();
        if (jt < NT - 1) { unsigned all = 1u;
#pragma unroll
            for (int w = 0; w < 8; ++w) all &= flags[((jt + 1) & 1) * 8 + w];
            if (all) break; }
        if (jt > 0) { AT_STAGE(kraw, vraw, (jt - 1) & 1);
            if (jt > 1) { kraw = *(const u32x4*)(kvp + (size_t)(jt - 2) * 64 * PMP); vraw = *(const u32x4*)(kvp + (size_t)(jt - 2) * 64 * PMP + 512); } }
        const int bo_ = (jt & 1) * AT_BUF;
        const int k0 = jt * 64;
        if (!wdone && k0 <= wq0) {
            f32x16 p0, p1;
#pragma unroll
            for (int r = 0; r < 16; ++r) { p0[r] = 0.f; p1[r] = 0.f; }
#pragma unroll
            for (int d0 = 0; d0 < 4; ++d0) { const bf16x8 b0 = *(const LAS bf16x8*)(kb + bo_ + d0 * 2048), b1 = *(const LAS bf16x8*)(kb + bo_ + d0 * 2048 + 512);
                p0 = __builtin_amdgcn_mfma_f32_32x32x16_bf16(b0, qr[d0], p0, 0, 0, 0); p1 = __builtin_amdgcn_mfma_f32_32x32x16_bf16(b1, qr[d0], p1, 0, 0, 0); }
            const bool needmask = (k0 + 63 >= wq0);
            float Lr[32], lb[32];
            if (needmask) {
#pragma unroll
                for (int i = 0; i < 32; ++i) { const float z = i < 16 ? p0[i] : p1[i - 16]; const int r = i & 15;
                    const float e = __builtin_amdgcn_exp2f(-fabsf(z)); const float sp = fmaxf(z, 0.f) + __builtin_amdgcn_logf(1.0f + e);
                    const bool valid = (k0 + (i >> 4) * 32 + crow(r, hi) < qi);
                    Lr[i] = valid ? -sp : 0.f; lb[i] = valid ? z - sp : -INFINITY; }
            } else {
#pragma unroll
                for (int i = 0; i < 32; ++i) { const float z = i < 16 ? p0[i] : p1[i - 16];
                    const float e = __builtin_amdgcn_exp2f(-fabsf(z)); const float sp = fmaxf(z, 0.f) + __builtin_amdgcn_logf(1.0f + e);
                    Lr[i] = -sp; lb[i] = z - sp; }
            }
            float Tj[8], ex[8];
#pragma unroll
            for (int j = 0; j < 8; ++j) { const float g = (Lr[4 * j] + Lr[4 * j + 1]) + (Lr[4 * j + 2] + Lr[4 * j + 3]);
                auto rr = __builtin_amdgcn_permlane32_swap(__float_as_uint(g), __float_as_uint(g), false, false);
                const float lo = __uint_as_float(rr[0]), hv = __uint_as_float(rr[1]); Tj[j] = lo + hv; ex[j] = hi ? 0.f : hv; }
            float suf = carry; float w[32];
#pragma unroll
            for (int j = 7; j >= 0; --j) { const float a3 = suf + ex[j], a2 = a3 + Lr[4 * j + 3], a1 = a2 + Lr[4 * j + 2], a0 = a1 + Lr[4 * j + 1];
                w[4 * j + 3] = __builtin_amdgcn_exp2f(lb[4 * j + 3] + a3); w[4 * j + 2] = __builtin_amdgcn_exp2f(lb[4 * j + 2] + a2);
                w[4 * j + 1] = __builtin_amdgcn_exp2f(lb[4 * j + 1] + a1); w[4 * j] = __builtin_amdgcn_exp2f(lb[4 * j] + a0);
                suf += Tj[j]; }
            carry = suf;
            wdone = __all(carry < THR2) != 0;
            const bf16x8 pa0 = __builtin_bit_cast(bf16x8, pack8(w)), pa1 = __builtin_bit_cast(bf16x8, pack8(w + 8)), pa2 = __builtin_bit_cast(bf16x8, pack8(w + 16)), pa3 = __builtin_bit_cast(bf16x8, pack8(w + 24));
            pv_acc(o0, o1, vb0 + bo_, pa0, pa1, pa2, pa3);
        }
        if (lane == 0) flags[(jt & 1) * 8 + wid] = wdone ? 1u : 0u;
    }
#undef AT_STAGE
    {
        LAS bf16_t* stg = (LAS bf16_t*)(lds + AT_OST) + wid * 2048;
#pragma unroll
        for (int r = 0; r < 16; ++r) { const int orow = crow(r, hi); stg[orow * 64 + r32] = f2bf(o0[r]); stg[orow * 64 + 32 + r32] = f2bf(o1[r]); }
        asm volatile("s_waitcnt lgkmcnt(0)" ::: "memory");
        bf16_t* Ow = PM + (rowbase + q0 + wid * 32) * PMP + 2560 + h * 64; size_t opitch = PMP;
        if (dmy) { Ow = dmy + (rowbase + q0 + wid * 32) * 512 + h * 64; opitch = 512; }
#pragma unroll
        for (int i = 0; i < 4; ++i) { const int row = i * 8 + (lane >> 3), c8 = lane & 7; const u32x4 v = *(const LAS u32x4*)(stg + row * 64 + c8 * 8); *(u32x4*)(Ow + (size_t)row * opitch + c8 * 8) = v; }
        asm volatile("s_waitcnt lgkmcnt(0)" ::: "memory");
    }
}

DI void sgu_unit(LAS unsigned char* lds, bf16_t* PM, const bf16_t* WsT, const float* lng, const float* lnb, const float* sb, int chunk, int g, bf16_t* dmy) {
    int tid_ = threadIdx.x; asm volatile("" : "+v"(tid_)); const int tid = tid_, lane = tid & 63, r32 = lane & 31, hi = lane >> 5, wid = __builtin_amdgcn_readfirstlane(tid >> 6);
    LAS bf16_t* vT = (LAS bf16_t*)lds;
    LAS float* dstf = (LAS float*)(lds + 36864);
    const size_t tok0 = (size_t)chunk * 128;
    const int tb = wid & 3, chh = wid >> 2;
    const bf16_t* Ap = WsT + (size_t)g * 16384 + (32 * tb + r32) * 128 + 8 * hi;
    bf16x8 Afr[8];
#pragma unroll
    for (int ks = 0; ks < 8; ++ks) { if (ks < 2 * (tb + 1)) Afr[ks] = *(const bf16x8*)(Ap + 16 * ks); else Afr[ks] = (bf16x8){0, 0, 0, 0, 0, 0, 0, 0}; }
    const int er = tid >> 4, ep = tid & 15;
    bf16_t* ubase = PM + (tok0 + er) * PMP + 1536 + 128 * g + 8 * ep;
    u32x4 uraw[4];
#pragma unroll
    for (int i = 0; i < 4; ++i) uraw[i] = *(const u32x4*)(ubase + (size_t)(32 * i) * PMP);
    u32x4 vr[16];
#pragma unroll
    for (int i = 0; i < 16; ++i) vr[i] = *(const u32x4*)(PM + (tok0 + 16 * wid + i) * PMP + 2048 + 8 * lane);
    const int s_ = tid >> 2, qd = tid & 3;
    u32x4 gr[4];
#pragma unroll
    for (int i = 0; i < 4; ++i) gr[i] = *(const u32x4*)(PM + (tok0 + s_) * PMP + 2048 + 128 * g + 32 * qd + 8 * i);
    __syncthreads();
    LAS f32x2* red = (LAS f32x2*)(lds + 36864) + wid * (16 * 65);
#pragma unroll
    for (int i = 0; i < 16; ++i) { float f[8]; unpack8(vr[i], f); float sm = 0.f, sq = 0.f;
#pragma unroll
        for (int e = 0; e < 8; ++e) { sm += f[e]; sq += f[e] * f[e]; }
        red[i * 65 + lane] = (f32x2){sm, sq}; }
    f32x2 mr;
    {
        __builtin_amdgcn_fence(__ATOMIC_RELEASE, "wavefront"); __builtin_amdgcn_wave_barrier(); __builtin_amdgcn_fence(__ATOMIC_ACQUIRE, "wavefront");
        f32x2 ac = {0.f, 0.f}; const LAS f32x2* rp = red + (lane >> 2) * 65 + (lane & 3) * 16;
#pragma unroll
        for (int j = 0; j < 16; ++j) ac += rp[j];
        ac.x += __shfl_xor(ac.x, 1); ac.y += __shfl_xor(ac.y, 1); ac.x += __shfl_xor(ac.x, 2); ac.y += __shfl_xor(ac.y, 2);
        const float mean = ac.x * (1.0f / 512.0f), var = fmaxf(ac.y * (1.0f / 512.0f) - mean * mean, 0.f);
        mr = (f32x2){mean, 1.0f / sqrtf(var + EPS)};
    }
    {
#pragma unroll
        for (int i = 0; i < 4; ++i) { const int c0 = 32 * qd + 8 * i; float f[8]; unpack8(gr[i], f);
            const f32x4 g0 = *(const f32x4*)(lng + 128 * g + c0), g1 = *(const f32x4*)(lng + 128 * g + c0 + 4), b0 = *(const f32x4*)(lnb + 128 * g + c0), b1 = *(const f32x4*)(lnb + 128 * g + c0 + 4);
#pragma unroll
            for (int e = 0; e < 4; ++e) { vT[(c0 + e) * 136 + s_] = f2bf((f[e] - mr.x) * mr.y * g0[e] + b0[e]); vT[(c0 + 4 + e) * 136 + s_] = f2bf((f[4 + e] - mr.x) * mr.y * g1[e] + b1[e]); } }
    }
    __syncthreads();
    f32x16 a0, a1;
#pragma unroll
    for (int r = 0; r < 16; ++r) { a0[r] = 0.f; a1[r] = 0.f; }
    const LAS bf16_t* Bp = vT + (64 * chh + r32) * 136 + 8 * hi;
#pragma unroll
    for (int ks = 0; ks < 8; ++ks) { if (ks < 2 * (tb + 1)) {
        const bf16x8 B0 = *(const LAS bf16x8*)(Bp + 16 * ks), B1 = *(const LAS bf16x8*)(Bp + 32 * 136 + 16 * ks);
        a0 = __builtin_amdgcn_mfma_f32_32x32x16_bf16(Afr[ks], B0, a0, 0, 0, 0); a1 = __builtin_amdgcn_mfma_f32_32x32x16_bf16(Afr[ks], B1, a1, 0, 0, 0); } }
#pragma unroll
    for (int r = 0; r < 16; ++r) { const int t = 32 * tb + crow(r, hi); const float bias = sb[g * 128 + t];
        dstf[t * 132 + 64 * chh + r32] = a0[r] + bias; dstf[t * 132 + 64 * chh + 32 + r32] = a1[r] + bias; }
    __syncthreads();
#pragma unroll
    for (int i = 0; i < 4; ++i) { const int t = er + 32 * i; float u[8], o[8]; unpack8(uraw[i], u);
        const f32x4 m0 = *(const LAS f32x4*)(dstf + t * 132 + 8 * ep), m1 = *(const LAS f32x4*)(dstf + t * 132 + 8 * ep + 4);
#pragma unroll
        for (int e = 0; e < 4; ++e) { o[e] = u[e] * m0[e]; o[4 + e] = u[4 + e] * m1[e]; }
        bf16_t* op = dmy ? dmy + (tok0 + t) * 512 + 128 * g + 8 * ep : ubase + (size_t)(32 * i) * PMP;
        *(u32x4*)op = pack8(o); }
}

DI void conv_unit(bf16_t* PM, const float* cw, const float* cb, int tile, bf16_t* dmy) {
    int tid_ = threadIdx.x; asm volatile("" : "+v"(tid_)); const int tid = tid_, lane = tid & 63, wid = tid >> 6; const int tok_s = tile * 64 + wid * 8, c0 = lane * 8;
    float w0[8], w1[8], w2[8], bb[8], um2[8], um1[8];
#pragma unroll
    for (int e = 0; e < 8; ++e) { w0[e] = cw[c0 + e]; w1[e] = cw[512 + c0 + e]; w2[e] = cw[1024 + c0 + e]; bb[e] = cb[c0 + e]; um2[e] = 0.f; um1[e] = 0.f; }
    const int pos0 = tok_s % SEQ_;
    if (pos0 >= 2) unpack8(*(const u32x4*)(PM + (size_t)(tok_s - 2) * PMP + 512 + c0), um2);
    if (pos0 >= 1) unpack8(*(const u32x4*)(PM + (size_t)(tok_s - 1) * PMP + 512 + c0), um1);
    u32x4 ru[8], rg[8];
#pragma unroll
    for (int t = 0; t < 8; ++t) { const bf16_t* row = PM + (size_t)(tok_s + t) * PMP; ru[t] = *(const u32x4*)(row + 512 + c0); rg[t] = *(const u32x4*)(row + c0); }
#pragma unroll
    for (int t = 0; t < 8; ++t) { bf16_t* row = PM + (size_t)(tok_s + t) * PMP; float uu[8], g[8], o[8];
        unpack8(ru[t], uu); unpack8(rg[t], g);
#pragma unroll
        for (int e = 0; e < 8; ++e) { const float y = bb[e] + w0[e] * um2[e] + w1[e] * um1[e] + w2[e] * uu[e]; o[e] = g[e] * y; um2[e] = um1[e]; um1[e] = uu[e]; }
        *(u32x4*)(dmy ? dmy + (size_t)(tok_s + t) * 512 + c0 : row + c0) = pack8(o); }
}

DI void mixer_phase(const Params& p, LAS unsigned char* lds, int l, bf16_t* dmy) {
    bf16_t* PM = (bf16_t*)(p.ws + WS_BIG);
    const int G = gridDim.x;
    const bool rev = ((blockIdx.x >> 3) & 1) != 0;
    for (int st = 0; st < 4; ++st) {
        const int which = rev ? 3 - st : st;
        if (which == 0) { for (int u = blockIdx.x; u < 512; u += G) attn_unit(lds, PM, p.qg + l * 64, p.kg + l * 64, u >> 8, (u >> 5) & 7, 31 - (u & 31), dmy); }
        else if (which == 1) { for (int u = blockIdx.x; u < 512; u += G) sgu_unit(lds, PM, (const bf16_t*)(p.ws + (size_t)l * WS_WL + W_SG), p.ln_g + l * 512, p.ln_b + l * 512, p.sgu_b + l * 512, u >> 2, u & 3, dmy); }
        else if (which == 2) { for (int u = blockIdx.x; u < 256; u += G) conv_unit(PM, p.conv_w + l * 1536, p.conv_b + l * 512, u, dmy); }
        else if (!dmy) {
            __syncthreads(); if (l == 0) convert_items(p, lds, I_MAIN, 2 * I_IN - I_MAIN + I_REST); else convert_items(p, lds, 2 * I_IN + I_REST, I_REST);
            asm volatile("s_waitcnt lgkmcnt(0)" ::: "memory"); __syncthreads(); }
    }
}


#define XB_TMO      128
#define XB_XCNT(j)  (256  + 64 * (j))
#define XB_XSUB(j)  (1280 + 64 * (j))
#define XB_XGEN(j)  (2304 + 64 * (j))
#define XB_TOP      3328
#define XB_TOPGEN   3392
#define XCD_BAR_WORDS 3456
#define XB_SPIN_CAP (1u << 22)
DI unsigned xb_ld(unsigned* p)              { return __hip_atomic_load(p, __ATOMIC_RELAXED, __HIP_MEMORY_SCOPE_AGENT); }
DI unsigned xb_add(unsigned* p, unsigned v) { return __hip_atomic_fetch_add(p, v, __ATOMIC_RELAXED, __HIP_MEMORY_SCOPE_AGENT); }
DI unsigned xb_xcc_id() { return (unsigned)__builtin_amdgcn_s_getreg((3 << 11) | 20) & 0xFu; }
#define XB_SPIN(cond, bar) do { unsigned _sp = 0; while (cond) { __builtin_amdgcn_s_sleep(1); \
    if ((++_sp & 255u) == 0u) { if (xb_ld(&(bar)[XB_TMO])) break; if (_sp > XB_SPIN_CAP) { atomicAdd(&(bar)[XB_TMO], 1u); break; } } } } while (0)
struct XcdBarrier { unsigned* bar; unsigned x; volatile LAS unsigned* st; };
DI XcdBarrier xcd_barrier_post(unsigned* bar, volatile LAS unsigned* st) {
    XcdBarrier b; b.bar = bar; b.x = xb_xcc_id(); b.st = st;
    if (threadIdx.x == 0) (void)xb_add(&bar[XB_XCNT(b.x)], 1u);
    return b;
}
DI void xcd_barrier_complete(unsigned* bar, unsigned x, unsigned& nloc, unsigned& nx) {
    const unsigned G = gridDim.x * gridDim.y * gridDim.z;
    unsigned sum, cnt, mine, sp = 0u;
    for (;;) {
        sum = 0u; cnt = 0u; mine = 0u;
#pragma unroll
        for (unsigned j = 0; j < 16; ++j) { const unsigned c = xb_ld(&bar[XB_XCNT(j)]); sum += c; cnt += (c > 0u) ? 1u : 0u; mine = (j == x) ? c : mine; }
        if (sum == G) break;
        __builtin_amdgcn_s_sleep(1);
        if ((++sp & 255u) == 0u) { if (xb_ld(&bar[XB_TMO])) break; if (sp > XB_SPIN_CAP) { atomicAdd(&bar[XB_TMO], 1u); break; } }
    }
    nloc = mine > 0u ? mine : 1u; nx = cnt > 0u ? cnt : 1u;
}
DI void xcd_barrier(const XcdBarrier& b) {
    asm volatile("s_waitcnt vmcnt(0)" ::: "memory");
    __syncthreads();
    if (threadIdx.x == 0) {
        unsigned* bar = b.bar;
        __builtin_amdgcn_s_waitcnt(0);
        unsigned nloc = b.st[0], nx = b.st[1];
        if (nloc == 0u) { xcd_barrier_complete(bar, b.x, nloc, nx); b.st[0] = nloc; b.st[1] = nx; }
        const unsigned old = xb_add(&bar[XB_XSUB(b.x)], 1u);
        const unsigned gen = old / nloc;
        if (old + 1u == (gen + 1u) * nloc) {
            __builtin_amdgcn_fence(__ATOMIC_RELEASE, "agent");
            asm volatile("s_waitcnt vmcnt(0)" ::: "memory");
            const unsigned og = xb_add(&bar[XB_TOP], 1u);
            const unsigned tg = og / nx;
            if (og + 1u == (tg + 1u) * nx) xb_add(&bar[XB_TOPGEN], 1u);
            else XB_SPIN(xb_ld(&bar[XB_TOPGEN]) == tg, bar);
            __builtin_amdgcn_fence(__ATOMIC_ACQUIRE, "agent");
            xb_add(&bar[XB_XGEN(b.x)], 1u);
            asm volatile("s_waitcnt vmcnt(0)" ::: "memory");
        } else {
            XB_SPIN(xb_ld(&bar[XB_XGEN(b.x)]) == gen, bar);
            __builtin_amdgcn_fence(__ATOMIC_ACQUIRE, "agent");
            asm volatile("s_waitcnt vmcnt(0)" ::: "memory");
        }
    }
    __syncthreads();
}

DI void panel_barrier(unsigned* cnt, unsigned target, bool same_xcd) {
    asm volatile("s_waitcnt vmcnt(0)" ::: "memory");
    __syncthreads();
    if (threadIdx.x == 0) {
        if (!same_xcd) { __builtin_amdgcn_fence(__ATOMIC_RELEASE, "agent"); asm volatile("s_waitcnt vmcnt(0)" ::: "memory"); }
        (void)xb_add(cnt, 1u);
        unsigned sp = 0;
        while (xb_ld(cnt) < target) { __builtin_amdgcn_s_sleep(1); if (++sp > (1u << 24)) break; }
        __builtin_amdgcn_fence(__ATOMIC_ACQUIRE, "agent"); asm volatile("s_waitcnt vmcnt(0)" ::: "memory");
    }
    __syncthreads();
}

__global__ void __launch_bounds__(512, 2) fwd_kernel(Params p) {
    extern __shared__ __attribute__((aligned(16))) unsigned char lds_raw[];
    LAS unsigned char* lds = (LAS unsigned char*)lds_raw;
    cg::grid_group grid = cg::this_grid();
    const int G = gridDim.x, c = blockIdx.x;
    bf16_t* PM = (bf16_t*)(p.ws + WS_BIG); bf16_t* XB = (bf16_t*)(p.ws + WS_XB); float* part = (float*)(p.ws + WS_PART); float* rsv = (float*)(p.ws + WS_RSV);
    volatile LAS unsigned* MISC = (volatile LAS unsigned*)(lds + 134144);
    if (threadIdx.x < 2) MISC[threadIdx.x] = 0u;
    __syncthreads();
    const XcdBarrier xbar = xcd_barrier_post((unsigned*)(p.ws + WS_BAR), MISC);
    unsigned* pcnt = (unsigned*)(p.ws + WS_BAR + 16384) + 64 * (8 * (c % 8) + ((c >> 3) & 7)); int npanel = 0;
    unsigned* xccs = (unsigned*)(p.ws + WS_XCC); bool same_xcd = false;
    if (threadIdx.x == 0) __hip_atomic_store(xccs + c, xbar.x + 1u, __ATOMIC_RELAXED, __HIP_MEMORY_SCOPE_AGENT);
    if (p.ph_hi > 1000) grid.sync();
    for (int ph = p.ph_lo; ph < p.ph_hi; ++ph) {
#ifndef PHMASK
#define PHMASK 127
#endif
#ifndef DUP_PH
#define DUP_PH -1
#endif
        const int reps = (ph == DUP_PH) ? 2 : 1;
        for (int rep = 0; rep < reps; ++rep) {
        bf16_t* dmy = (reps == 2 && rep == 0) ? (bf16_t*)(p.ws + WS_DMY) : nullptr;
        if (ph == 0) {
            if (G == 256) {
                phase0(p, lds, 0, 0);
                xcd_barrier(xbar);
                { const int c0 = c & 63; unsigned ok = 1u;
#pragma unroll
                    for (int j = 0; j < 4; ++j) ok &= (xb_ld(xccs + c0 + 64 * j) == xbar.x + 1u) ? 1u : 0u;
                    same_xcd = ok != 0u; }
                phase0(p, lds, 2, (8 * (c % 8) + ((c >> 3) & 7)) * 256 + (c >> 6) * 64);
            } else phase0(p, lds, 1, 0);
        }
        else {
            const int l = (ph - 1) / 6, k = (ph - 1) % 6; const unsigned char* wl = p.ws + (size_t)l * WS_WL;
            if (k == 0 && (PHMASK & 2)) {
                pg8::SchedPlain S; S.o.init(T_, NMAIN, G, c); S.A = (const char*)XB; S.B = (const char*)(wl + W_IN); S.lda2 = 2048; S.ldb2 = 2048; S.nt = 16; S.astride = 256 * 2048;
                S.rev_n = (G == 256 && ((c >> 3) & 1)) ? 4 : 0;
                pg8::EpiMain E{PM, part, rsv}; pg8::gemm_phase(lds, S, E);
            } else if (k == 1 && (PHMASK & 4)) {
                mixer_phase(p, lds, l, dmy);
            } else if (k == 2 && (PHMASK & 8)) {
                pg8::SchedBO S; S.o.init(T_, D_, G, c); S.XB = (const char*)XB; S.PM = (const char*)PM; S.WgT = (const char*)(wl + W_IN) + (size_t)NMAIN * 2048; S.WboT = (const char*)(wl + W_BO);
                pg8::EpiBO E{PM, rsv, p.b_gate + l * 3072}; pg8::gemm_phase(lds, S, E);
            } else if ((k == 3 || k == 5) && (PHMASK & 16)) {
                pg8::SchedPlain S; S.o.init(T_, D_, G, c);
                if (k == 3) { S.A = (const char*)(PM + COL_MG); S.B = (const char*)(wl + W_O); S.lda2 = PMP * 2; S.ldb2 = 2048; S.nt = 16; S.astride = (size_t)256 * PMP * 2; }
                else { S.A = (const char*)PM; S.B = (const char*)(wl + W_DN); S.lda2 = DFF * 2; S.ldb2 = DFF * 2; S.nt = DFF / 64; S.astride = (size_t)256 * PMP * 2; }
                pg8::EpiRes E{(k == 5 && l == 1) ? p.out : nullptr, XB, part}; pg8::gemm_phase(lds, S, E);
            } else if (k == 4 && (PHMASK & 32)) {
                if ((NGU / 256 * 64 - c + G - 1) / G < (NGU / 256 * 64 + G - 1) / G) { for (int i = 0; i < 3; ++i) __builtin_amdgcn_s_sleep(127); }
                pg8::SchedPlain S; S.o.init(T_, NGU, G, c); S.A = (const char*)XB; S.B = (const char*)(wl + W_GU); S.lda2 = 2048; S.ldb2 = 2048; S.nt = 16; S.astride = 256 * 2048;
                pg8::EpiGU E{PM, part}; pg8::gemm_phase(lds, S, E);
            }
        }
        if (rep + 1 < reps) __syncthreads();
        }
        if (ph + 1 < p.ph_hi) {
            const int kk = (ph == 0) ? -1 : (ph - 1) % 6;
            if (G == 256 && (kk >= 2 || ph == 0)) { ++npanel; panel_barrier(pcnt, 4u * (unsigned)npanel, same_xcd); }
            else { xcd_barrier(xbar);
                if (ph == 0 && G == 256) { const int c0 = c & 63; unsigned ok = 1u;
#pragma unroll
                    for (int j = 0; j < 4; ++j) ok &= (xb_ld(xccs + c0 + 64 * j) == xbar.x + 1u) ? 1u : 0u;
                    same_xcd = ok != 0u; } }
        }
    }
}

#ifndef N_LAUNCH_SPLIT
#define N_LAUNCH_SPLIT 0
#endif
extern "C" void kernel_launch(void* const* d_in, const int* in_sizes, int n_in, void* d_out, int out_size, void* d_ws, size_t ws_size, hipStream_t stream) {
    static int grid = 0;
    if (grid == 0) {
        if (n_in != 17 || out_size != T_ * D_ || ws_size < WS_END + 262144) { fprintf(stderr, "kernel_launch: unexpected shapes (n_in %d out %d ws %zu)\n", n_in, out_size, ws_size); grid = -1; return; }
        int dev = 0, cus = 0, per_cu = 0;
        hipGetDevice(&dev); hipDeviceGetAttribute(&cus, hipDeviceAttributeMultiprocessorCount, dev);
        hipFuncSetAttribute((const void*)fwd_kernel, hipFuncAttributeMaxDynamicSharedMemorySize, LDS_BYTES);
        hipOccupancyMaxActiveBlocksPerMultiprocessor(&per_cu, (const void*)fwd_kernel, 512, LDS_BYTES);
        if (per_cu < 1) { fprintf(stderr, "kernel_launch: occupancy query says %d blocks/CU\n", per_cu); per_cu = 1; }
        (void)hipGetLastError();
        grid = cus * 1;
    }
    if (grid < 0) return;
    Params p{};
    p.x = (const float*)d_in[0]; p.mix_g = (const float*)d_in[1]; p.w_in = (const float*)d_in[2]; p.b_gate = (const float*)d_in[3]; p.conv_w = (const float*)d_in[4]; p.conv_b = (const float*)d_in[5];
    p.ln_g = (const float*)d_in[6]; p.ln_b = (const float*)d_in[7]; p.sgu_w = (const float*)d_in[8]; p.sgu_b = (const float*)d_in[9]; p.qg = (const float*)d_in[10]; p.kg = (const float*)d_in[11];
    p.w_bo = (const float*)d_in[12]; p.w_o = (const float*)d_in[13]; p.ffn_g = (const float*)d_in[14]; p.w_gu = (const float*)d_in[15]; p.w_dn = (const float*)d_in[16];
    p.out = (float*)d_out; p.ws = (unsigned char*)d_ws;
#if N_LAUNCH_SPLIT
    for (int ph = 0; ph < 13; ++ph) { p.ph_lo = ph; p.ph_hi = ph + 1; hipLaunchKernelGGL(fwd_kernel, dim3(grid), dim3(512), LDS_BYTES, stream, p); }
#else
    p.ph_lo = 0; p.ph_hi = 13;
    (void)hipMemsetAsync((char*)d_ws + WS_BAR, 0, 32768, stream);
    void* args[] = {&p};
    hipError_t e = hipLaunchCooperativeKernel((const void*)fwd_kernel, dim3(grid), dim3(512), args, LDS_BYTES, stream);
    if (e != hipSuccess) fprintf(stderr, "cooperative launch failed: %s (grid %d)\n", hipGetErrorString(e), grid);
#endif
}
```

```cpp
#include <hip/hip_runtime.h>
#include <hip/hip_cooperative_groups.h>
#include <cstdio>
#include <cstdint>
#include <cmath>
namespace cg = cooperative_groups;

#define LAS __attribute__((address_space(3)))
#define DI __device__ __forceinline__
typedef unsigned short bf16_t;
typedef short bf16x8 __attribute__((ext_vector_type(8)));
typedef float f32x4 __attribute__((ext_vector_type(4)));
typedef float f32x2 __attribute__((ext_vector_type(2)));
typedef float f32x16 __attribute__((ext_vector_type(16)));
typedef unsigned u32x4 __attribute__((ext_vector_type(4)));
typedef unsigned u32x2 __attribute__((ext_vector_type(2)));
typedef short s16x4 __attribute__((ext_vector_type(4)));

constexpr int T_ = 16384, D_ = 1024, SEQ_ = 8192, NMAIN = 4096, NIN = 7168, DFF = 2816, NGU = 5632;
constexpr int PMP = 4096 + 64;
constexpr int COL_GS = 512, COL_MG = 3072;
constexpr float EPS = 1e-6f;
constexpr float C2 = 0.125f * 1.4426950408889634f;
constexpr float THR2 = -150.0f;

constexpr size_t MiB = 1u << 20;
constexpr size_t WS_WL = 36 * MiB;
constexpr size_t W_IN = 0, W_BO = 14 * MiB, W_O = 17 * MiB, W_GU = 19 * MiB, W_DN = 30 * MiB, W_SG = 35 * MiB + 512 * 1024;
constexpr size_t WS_PART = 72 * MiB, WS_XB = 73 * MiB, WS_BIG = 105 * MiB, WS_END = 236 * MiB, WS_BAR = 236 * MiB, WS_RSV = 236 * MiB + 64 * 1024, WS_DMY = 237 * MiB, WS_XCC = 236 * MiB + 192 * 1024;

constexpr int LDS_BYTES = 135168;

typedef __bf16 bf16x2_t __attribute__((ext_vector_type(2)));
DI unsigned cvt_pk_bf16(float lo, float hi) { f32x2 v = {lo, hi}; bf16x2_t b = __builtin_convertvector(v, bf16x2_t); return __builtin_bit_cast(unsigned, b); }
DI float bf_lo(unsigned w) { return __uint_as_float(w << 16); }
DI float bf_hi(unsigned w) { return __uint_as_float(w & 0xffff0000u); }
DI float bf2f(bf16_t v) { return __uint_as_float(((unsigned)v) << 16); }
DI bf16_t f2bf(float f) { return (bf16_t)(cvt_pk_bf16(f, 0.f) & 0xffffu); }
DI void unpack8(const u32x4 w, float* f) { f[0] = bf_lo(w.x); f[1] = bf_hi(w.x); f[2] = bf_lo(w.y); f[3] = bf_hi(w.y); f[4] = bf_lo(w.z); f[5] = bf_hi(w.z); f[6] = bf_lo(w.w); f[7] = bf_hi(w.w); }
DI u32x4 pack8(const float* f) { u32x4 w; w.x = cvt_pk_bf16(f[0], f[1]); w.y = cvt_pk_bf16(f[2], f[3]); w.z = cvt_pk_bf16(f[4], f[5]); w.w = cvt_pk_bf16(f[6], f[7]); return w; }
DI float wave_sum(float v) {
#pragma unroll
    for (int o = 1; o < 64; o <<= 1) v += __shfl_xor(v, o);
    return v;
}
DI float sigmoidf_(float x) { return __builtin_amdgcn_rcpf(1.0f + __builtin_amdgcn_exp2f(-1.4426950408889634f * x)); }
DI f32x2 gelu_pk(f32x2 v) {
    const f32x2 av = __builtin_elementwise_abs(v), d = av * 0.2316418882f + 1.0f;
    f32x2 t; t.x = __builtin_amdgcn_rcpf(d.x); t.y = __builtin_amdgcn_rcpf(d.y);
    f32x2 q = t * 0.5307027145f + (-0.7265760135f); q = q * t + 0.7107068705f; q = q * t + (-0.142248368f); q = q * t + 0.127414796f; q = q * t;
    const f32x2 s = (v * v) * (-0.72134752044f);
    f32x2 e; e.x = __builtin_amdgcn_exp2f(s.x); e.y = __builtin_amdgcn_exp2f(s.y);
    const f32x2 m = v * (q * e), r = v - m;
    f32x2 o; o.x = v.x < 0.f ? m.x : r.x; o.y = v.y < 0.f ? m.y : r.y; return o;
}
DI f32x4 gelu4(f32x4 v) { f32x2 a = gelu_pk((f32x2){v[0], v[1]}), b = gelu_pk((f32x2){v[2], v[3]}); return (f32x4){a.x, a.y, b.x, b.y}; }

namespace pg8 {
constexpr int BM = 256, BK = 64, HALF = 128, HTB = HALF * BK * 2, STAGE_BYTES = 8 * HTB, NXCD = 8, WGM = 8;
DI int lds_byte(int r, int c) { const int st = (r >> 4) * 2 + (c >> 5), rr = r & 15, cc = c & 31, ob = rr * 64 + cc * 2; return st * 1024 + (ob ^ (((ob >> 9) & 1) << 5)); }
DI void stage_rc(int b, int& R, int& C) { const int st = b / 1024, sb = b % 1024, swz = sb ^ (((sb >> 9) & 1) << 5); R = (st >> 1) * 16 + swz / 64; C = (st & 1) * 32 + (swz % 64) / 2; }
DI int perm32(int rho) { const int n = rho >> 4, i = rho & 15; return 8 * (i >> 2) + 4 * n + (i & 3); }

struct UnitD { const char* A; const char* B; unsigned lda2, ldb2; int nt; int pm, pn, aux; };

struct TileOrder {
    int nM, nN, nwg, G, c;
    DI void init(int M, int N, int G_, int c_) { nM = M / BM; nN = N / BM; nwg = nM * nN; G = G_; c = c_; }
    DI bool tile(int i, int& pm, int& pn) const {
        const long L = (long)i * G + c; if (L >= nwg) return false;
        int wgid = (int)L; { const int q = nwg / NXCD, r = nwg % NXCD, xcd = wgid % NXCD, off = wgid / NXCD; wgid = (xcd < r ? xcd * (q + 1) : r * (q + 1) + (xcd - r) * q) + off; }
        const int nig = WGM * nN, gid = wgid / nig, fm = gid * WGM, gsz = (nM - fm) < WGM ? (nM - fm) : WGM;
        pm = fm + ((wgid % nig) % gsz); pn = (wgid % nig) / gsz; return true;
    }
};
struct SchedPlain {
    static constexpr bool UNIFORM_LD = true;
    TileOrder o; const char* A; const char* B; unsigned lda2, ldb2; int nt; size_t astride;
    DI bool get(int i, UnitD& u) const { int pm, pn; if (!o.tile(i, pm, pn)) return false; u.pm = pm; u.pn = pn; u.aux = 0;
        u.A = A + (size_t)pm * astride; u.B = B + (size_t)pn * BM * ldb2; u.lda2 = lda2; u.ldb2 = ldb2; u.nt = nt; return true; }
};
struct SchedBO {
    static constexpr bool UNIFORM_LD = false;
    TileOrder o; const char* XB; const char* PM; const char* WgT; const char* WboT;
    DI bool get(int i, UnitD& u) const { const int ti = i / 6, sub = i - ti * 6, br = sub >> 1; int pm, pn; if (!o.tile(ti, pm, pn)) return false; u.pm = pm; u.pn = pn; u.aux = sub;
        if ((sub & 1) == 0) { u.A = XB + (size_t)pm * BM * 2048; u.lda2 = 2048; u.B = WgT + (size_t)(br * 1024 + pn * BM) * 2048; u.ldb2 = 2048; u.nt = 16; }
        else { const int yc = br == 0 ? 0 : (br == 1 ? 1536 : 2560); u.A = PM + (size_t)pm * BM * (PMP * 2) + yc * 2; u.lda2 = PMP * 2; u.B = WboT + (size_t)(br * 1024 + pn * BM) * 1024; u.ldb2 = 1024; u.nt = 8; }
        return true; }
};

DI void row_rs8(const float* part, int row0, int fq, float (&rs)[2][4]) {
    f32x4 v[2][4];
#pragma unroll
    for (int ai = 0; ai < 2; ++ai)
#pragma unroll
        for (int m = 0; m < 4; ++m) v[ai][m] = *((const f32x4*)(part + (size_t)(row0 + ai * HALF + m * 16) * 16) + fq);
#pragma unroll
    for (int ai = 0; ai < 2; ++ai)
#pragma unroll
        for (int m = 0; m < 4; ++m) { float s_ = (v[ai][m][0] + v[ai][m][1]) + (v[ai][m][2] + v[ai][m][3]); s_ += __shfl_xor(s_, 16); s_ += __shfl_xor(s_, 32); rs[ai][m] = 1.0f / sqrtf(s_ * (1.0f / 1024.0f) + EPS); }
}
template <class Epi, class Sched>
DI void gemm_phase(LAS unsigned char* lds, const Sched& S, const Epi& E) {
    int tid_ = threadIdx.x; asm volatile("" : "+v"(tid_)); const int tid = tid_, wid = __builtin_amdgcn_readfirstlane(tid >> 6), lane = tid & 63, wr = wid >> 2, wc = wid & 3, fr = lane & 15, fq = lane >> 4;
#define PG8_VOFFS(lda_, ldb_, oA0, oA1, oB0, oB1) do { int t2_ = tid; asm volatile("" : "+v"(t2_)); int R0_, C0_, R1_, C1_; stage_rc(t2_ * 16, R0_, C0_); stage_rc(t2_ * 16 + 8192, R1_, C1_); \
        const int Rb0_ = (R0_ & ~31) + perm32(R0_ & 31), Rb1_ = (R1_ & ~31) + perm32(R1_ & 31); \
        oA0 = (unsigned)R0_ * (lda_) + C0_ * 2; oA1 = (unsigned)R1_ * (lda_) + C1_ * 2; oB0 = (unsigned)Rb0_ * (ldb_) + C0_ * 2; oB1 = (unsigned)Rb1_ * (ldb_) + C1_ * 2; } while (0)
    const size_t kstep = (size_t)(BK * 2);
    const unsigned ldsw = (unsigned)wid * 1024u;
    const int aoff = lds_byte(wr * 64 + fr, fq * 8), boff = lds_byte(wc * 32 + fr, fq * 8);
#define PG8_SA(b, h) (((b) * 2 + (h)) * HTB)
#define PG8_SB(b, h) ((4 + (b) * 2 + (h)) * HTB)
#define PG8_STAGE(bufoff, gbase, v0, v1) do { \
        __builtin_amdgcn_global_load_lds((const unsigned*)((const char*)(gbase) + (v0)), (LAS unsigned*)(lds + (bufoff) + ldsw), 16, 0, 0); \
        __builtin_amdgcn_global_load_lds((const unsigned*)((const char*)(gbase) + (v1)), (LAS unsigned*)(lds + (bufoff) + ldsw + 8192), 16, 0, 0); } while (0)
#define PG8_LDA(dst, b, h) do { _Pragma("unroll") for (int m = 0; m < 4; ++m) _Pragma("unroll") for (int k = 0; k < 2; ++k) dst[m][k] = *(const LAS bf16x8*)(lds + PG8_SA(b, h) + aoff + m * 2048 + k * 1024); } while (0)
#define PG8_LDB(dst, b, h) do { _Pragma("unroll") for (int n = 0; n < 2; ++n) _Pragma("unroll") for (int k = 0; k < 2; ++k) dst[n][k] = *(const LAS bf16x8*)(lds + PG8_SB(b, h) + boff + n * 2048 + k * 1024); } while (0)
#define PG8_MMA(ai, bj, At, Bt) do { __builtin_amdgcn_s_setprio(1); _Pragma("unroll") for (int m = 0; m < 4; ++m) _Pragma("unroll") for (int n = 0; n < 2; ++n) _Pragma("unroll") for (int k = 0; k < 2; ++k) \
        acc[ai][bj][m][n] = __builtin_amdgcn_mfma_f32_16x16x32_bf16(Bt[n][k], At[m][k], acc[ai][bj][m][n], 0, 0, 0); __builtin_amdgcn_s_setprio(0); } while (0)
#define PG8_WAIT_V(n) asm volatile("s_waitcnt vmcnt(" #n ")" ::: "memory")
#define PG8_WAIT_L(n) asm volatile("s_waitcnt lgkmcnt(" #n ")" ::: "memory")
#define PG8_BAR __builtin_amdgcn_s_barrier()
#define PG8_SCHED __builtin_amdgcn_sched_barrier(0)
    UnitD cur, nxt; int ui = 0;
    if (!S.get(0, cur)) return;
    float rsc[2][4]; int rs_pm = cur.pm;
    if constexpr (Epi::NEEDS_RS) row_rs8(E.part, cur.pm * BM + wr * 64 + fr, fq, rsc);
    f32x4 acc[2][2][4][2];
#pragma unroll
    for (int a = 0; a < 2; ++a)
#pragma unroll
        for (int b = 0; b < 2; ++b)
#pragma unroll
            for (int m = 0; m < 4; ++m)
#pragma unroll
                for (int n = 0; n < 2; ++n) acc[a][b][m][n] = (f32x4){0.f, 0.f, 0.f, 0.f};
    bf16x8 At[4][2], B0[2][2], B1[2][2];
    const char* cA = cur.A; const char* cB = cur.B;
    unsigned vA0, vA1, vB0, vB1; PG8_VOFFS(cur.lda2, cur.ldb2, vA0, vA1, vB0, vB1);
    size_t hA = (size_t)HALF * cur.lda2, hB = (size_t)HALF * cur.ldb2;
    PG8_STAGE(PG8_SB(0, 0), cB, vB0, vB1); PG8_STAGE(PG8_SB(0, 1), cB + hB, vB0, vB1); PG8_STAGE(PG8_SA(0, 0), cA, vA0, vA1); PG8_STAGE(PG8_SA(0, 1), cA + hA, vA0, vA1);
    if (wr == 1) PG8_BAR;
    PG8_WAIT_V(2); PG8_BAR;
    PG8_STAGE(PG8_SB(1, 0), cB + kstep, vB0, vB1); PG8_STAGE(PG8_SA(1, 0), cA + kstep, vA0, vA1); PG8_STAGE(PG8_SB(1, 1), cB + hB + kstep, vB0, vB1);
    PG8_WAIT_V(6); PG8_BAR;
    for (;;) {
        const bool has_next = S.get(ui + 1, nxt);
        const char* nA = has_next ? nxt.A : cA; const char* nB = has_next ? nxt.B : cB;
        unsigned nvA0 = vA0, nvA1 = vA1, nvB0 = vB0, nvB1 = vB1; size_t nhA = hA, nhB = hB;
        if constexpr (!Sched::UNIFORM_LD) {
            const unsigned nlda = has_next ? nxt.lda2 : cur.lda2, nldb = has_next ? nxt.ldb2 : cur.ldb2;
            PG8_VOFFS(nlda, nldb, nvA0, nvA1, nvB0, nvB1); nhA = (size_t)HALF * nlda; nhB = (size_t)HALF * nldb;
        }
        const int nt = cur.nt;
        for (int t = 0; t < nt; t += 2) {
            const bool last = (t == nt - 2);
            const char* a1 = cA + (size_t)(t + 1) * kstep;
            const char* a2 = last ? nA : cA + (size_t)(t + 2) * kstep; const char* b2 = last ? nB : cB + (size_t)(t + 2) * kstep;
            const char* a3 = a2 + kstep; const char* b3 = b2 + kstep;
            const unsigned xA0 = last ? nvA0 : vA0, xA1 = last ? nvA1 : vA1, xB0 = last ? nvB0 : vB0, xB1 = last ? nvB1 : vB1;
            const size_t xhA = last ? nhA : hA, xhB = last ? nhB : hB;
            PG8_LDB(B0, 0, 0); PG8_LDB(B1, 0, 1); PG8_SCHED; PG8_LDA(At, 0, 0); PG8_STAGE(PG8_SA(1, 1), a1 + hA, vA0, vA1);
            PG8_WAIT_V(8); PG8_WAIT_L(0); PG8_BAR; PG8_MMA(0, 0, At, B0); PG8_MMA(0, 1, At, B1); PG8_BAR; PG8_SCHED;
            PG8_LDA(At, 0, 1); PG8_STAGE(PG8_SB(0, 0), b2, xB0, xB1); PG8_STAGE(PG8_SB(0, 1), b2 + xhB, xB0, xB1); PG8_STAGE(PG8_SA(0, 0), a2, xA0, xA1);
            PG8_WAIT_V(8); PG8_WAIT_L(0); PG8_BAR; PG8_MMA(1, 0, At, B0); PG8_MMA(1, 1, At, B1); PG8_BAR; PG8_SCHED;
            PG8_LDB(B0, 1, 0); PG8_LDB(B1, 1, 1); PG8_SCHED; PG8_LDA(At, 1, 0); PG8_STAGE(PG8_SA(0, 1), a2 + xhA, xA0, xA1);
            PG8_WAIT_V(8); PG8_WAIT_L(0); PG8_BAR; PG8_MMA(0, 0, At, B0); PG8_MMA(0, 1, At, B1); PG8_BAR; PG8_SCHED;
            PG8_LDA(At, 1, 1); PG8_STAGE(PG8_SB(1, 0), b3, xB0, xB1); PG8_STAGE(PG8_SB(1, 1), b3 + xhB, xB0, xB1); PG8_STAGE(PG8_SA(1, 0), a3, xA0, xA1);
            PG8_WAIT_V(8); PG8_WAIT_L(0); PG8_BAR; PG8_MMA(1, 0, At, B0); PG8_MMA(1, 1, At, B1); PG8_BAR; PG8_SCHED;
        }
        if (wr == 0) PG8_BAR;
        if constexpr (Epi::NEEDS_RS) { if (cur.pm != rs_pm) { row_rs8(E.part, cur.pm * BM + wr * 64 + fr, fq, rsc); rs_pm = cur.pm; } E(acc, cur, wr, wc, fr, fq, rsc); }
        else E(acc, cur, wr, wc, fr, fq);
        if (!has_next) break;
#pragma unroll
        for (int a = 0; a < 2; ++a)
#pragma unroll
            for (int b = 0; b < 2; ++b)
#pragma unroll
                for (int m = 0; m < 4; ++m)
#pragma unroll
                    for (int n = 0; n < 2; ++n) acc[a][b][m][n] = (f32x4){0.f, 0.f, 0.f, 0.f};
        cur = nxt; cA = nA; cB = nB; ++ui; vA0 = nvA0; vA1 = nvA1; vB0 = nvB0; vB1 = nvB1; hA = nhA; hB = nhB;
        if (wr == 1) PG8_BAR;
    }
    PG8_WAIT_V(0);
    PG8_BAR;
#undef PG8_VOFFS
#undef PG8_SA
#undef PG8_SB
#undef PG8_STAGE
#undef PG8_LDA
#undef PG8_LDB
#undef PG8_MMA
#undef PG8_WAIT_V
#undef PG8_WAIT_L
#undef PG8_BAR
#undef PG8_SCHED
}

DI u32x4 pk8(const f32x4 v0, const f32x4 v1) { u32x4 w; w.x = cvt_pk_bf16(v0[0], v0[1]); w.y = cvt_pk_bf16(v0[2], v0[3]); w.z = cvt_pk_bf16(v1[0], v1[1]); w.w = cvt_pk_bf16(v1[2], v1[3]); return w; }

struct EpiMain {
    static constexpr bool NEEDS_RS = true;
    bf16_t* PM; const float* part; float* rsv;
    DI void operator()(const f32x4 (&acc)[2][2][4][2], const UnitD& u, int wr, int wc, int fr, int fq, const float (&rs)[2][4]) const {
        const int row0 = u.pm * BM + wr * 64 + fr, col0 = u.pn * BM + wc * 32 + 8 * fq; const bool gl = (u.pn >= 6 && u.pn < 10);
#pragma unroll
        for (int ai = 0; ai < 2; ++ai)
#pragma unroll
            for (int m = 0; m < 4; ++m) { const int row = row0 + ai * HALF + m * 16; const float r_ = rs[ai][m]; bf16_t* rowp = PM + (size_t)row * PMP + col0;
                if (u.pn == 0 && wc == 0 && fq == 0) rsv[row] = r_;
                if (u.pn >= 2 && u.pn < 6) {
                    float o[8];
#pragma unroll
                    for (int n = 0; n < 2; ++n) { const f32x4 cg = acc[ai][0][m][n] * r_, xa = acc[ai][1][m][n] * r_;
#pragma unroll
                        for (int e = 0; e < 4; ++e) o[4 * n + e] = cg[e] * xa[e]; }
                    *(u32x4*)(PM + (size_t)row * PMP + 512 + 128 * (u.pn - 2) + wc * 32 + 8 * fq) = pack8(o);
                } else {
#pragma unroll
                for (int bj = 0; bj < 2; ++bj) { f32x4 v0 = acc[ai][bj][m][0] * r_, v1 = acc[ai][bj][m][1] * r_; if (gl) { v0 = gelu4(v0); v1 = gelu4(v1); }
                    *(u32x4*)(rowp + bj * HALF) = pk8(v0, v1); } } }
    }
};
struct EpiBO {
    static constexpr bool NEEDS_RS = false;
    bf16_t* PM; const float* rsv; const float* bgate;
    DI void operator()(const f32x4 (&acc)[2][2][4][2], const UnitD& u, int wr, int wc, int fr, int fq) const {
        const int row0 = u.pm * BM + wr * 64 + fr, col0 = u.pn * BM + wc * 32 + 8 * fq, br = u.aux >> 1;
        if ((u.aux & 1) == 0) {
            f32x4 bv[2][2]; float rs[2][4];
#pragma unroll
            for (int bj = 0; bj < 2; ++bj)
#pragma unroll
                for (int n = 0; n < 2; ++n) bv[bj][n] = *(const f32x4*)(bgate + br * 1024 + col0 + bj * HALF + 4 * n);
#pragma unroll
            for (int ai = 0; ai < 2; ++ai)
#pragma unroll
                for (int m = 0; m < 4; ++m) rs[ai][m] = rsv[row0 + ai * HALF + m * 16];
#pragma unroll
            for (int ai = 0; ai < 2; ++ai)
#pragma unroll
                for (int m = 0; m < 4; ++m) { const int row = row0 + ai * HALF + m * 16; const float r_ = rs[ai][m];
#pragma unroll
                    for (int bj = 0; bj < 2; ++bj) { f32x4 v0 = acc[ai][bj][m][0] * r_ + bv[bj][0], v1 = acc[ai][bj][m][1] * r_ + bv[bj][1];
                        unsigned q0 = 0u, q1 = 0u;
#pragma unroll
                        for (int e = 0; e < 4; ++e) { q0 |= (unsigned)(sigmoidf_(v0[e]) * 255.0f + 0.5f) << (8 * e); q1 |= (unsigned)(sigmoidf_(v1[e]) * 255.0f + 0.5f) << (8 * e); }
                        *(u32x2*)((unsigned char*)(PM + (size_t)row * PMP + COL_GS) + col0 + bj * HALF) = (u32x2){q0, q1}; } }
        } else {
#pragma unroll
            for (int ai = 0; ai < 2; ++ai) {
                u32x2 gw[4][2]; u32x4 mw[4][2];
#pragma unroll
                for (int m = 0; m < 4; ++m)
#pragma unroll
                    for (int bj = 0; bj < 2; ++bj) { const size_t rr_ = (size_t)(row0 + ai * HALF + m * 16) * PMP, ro = rr_ + col0 + bj * HALF; gw[m][bj] = *(const u32x2*)((const unsigned char*)(PM + rr_ + COL_GS) + col0 + bj * HALF); mw[m][bj] = (br > 0) ? *(const u32x4*)(PM + ro + COL_MG) : (u32x4){0u, 0u, 0u, 0u}; }
#pragma unroll
                for (int m = 0; m < 4; ++m)
#pragma unroll
                    for (int bj = 0; bj < 2; ++bj) { float g[8], o[8], pv_[8]; unpack8(mw[m][bj], pv_);
#pragma unroll
                        for (int e = 0; e < 4; ++e) { g[e] = (float)((gw[m][bj].x >> (8 * e)) & 0xffu) * (1.0f / 255.0f); g[4 + e] = (float)((gw[m][bj].y >> (8 * e)) & 0xffu) * (1.0f / 255.0f); }
                        const f32x4 a0 = acc[ai][bj][m][0], a1 = acc[ai][bj][m][1];
#pragma unroll
                        for (int e = 0; e < 4; ++e) { o[e] = a0[e] * g[e] + pv_[e]; o[4 + e] = a1[e] * g[4 + e] + pv_[4 + e]; }
                        *(u32x4*)(PM + (size_t)(row0 + ai * HALF + m * 16) * PMP + col0 + bj * HALF + COL_MG) = pack8(o); }
                asm volatile("" ::: "memory");
            }
        }
    }
};
struct EpiRes {
    static constexpr bool NEEDS_RS = false;
    float* out; bf16_t* XB; float* part;
    DI void operator()(const f32x4 (&acc)[2][2][4][2], const UnitD& u, int wr, int wc, int fr, int fq) const {
        const int row0 = u.pm * BM + wr * 64 + fr, col0 = u.pn * BM + wc * 32 + 8 * fq;
        u32x4 xw[2][4][2];
#pragma unroll
        for (int ai = 0; ai < 2; ++ai)
#pragma unroll
            for (int m = 0; m < 4; ++m)
#pragma unroll
                for (int bj = 0; bj < 2; ++bj) xw[ai][m][bj] = *(const u32x4*)(XB + (size_t)(row0 + ai * HALF + m * 16) * D_ + col0 + bj * HALF);
#pragma unroll
        for (int ai = 0; ai < 2; ++ai)
#pragma unroll
            for (int m = 0; m < 4; ++m) { const int row = row0 + ai * HALF + m * 16; const size_t off = (size_t)row * D_ + col0; float ss = 0.f;
#pragma unroll
                for (int bj = 0; bj < 2; ++bj) { float b[8]; unpack8(xw[ai][m][bj], b);
                    const f32x4 a0 = acc[ai][bj][m][0], a1 = acc[ai][bj][m][1];
                    const f32x4 x0 = (f32x4){b[0] + a0[0], b[1] + a0[1], b[2] + a0[2], b[3] + a0[3]}, x1 = (f32x4){b[4] + a1[0], b[5] + a1[1], b[6] + a1[2], b[7] + a1[3]};
                    if (out) { *(f32x4*)(out + off + bj * HALF) = x0; *(f32x4*)(out + off + bj * HALF + 4) = x1; }
                    else { *(u32x4*)(XB + off + bj * HALF) = pk8(x0, x1);
                        ss += ((x0[0] * x0[0] + x0[1] * x0[1]) + (x0[2] * x0[2] + x0[3] * x0[3])) + ((x1[0] * x1[0] + x1[1] * x1[1]) + (x1[2] * x1[2] + x1[3] * x1[3])); } }
                if (!out) { ss += __shfl_xor(ss, 16); ss += __shfl_xor(ss, 32);
                    if (fq == 0) part[(size_t)row * 16 + u.pn * 4 + wc] = ss; } }
    }
};
struct EpiGU {
    static constexpr bool NEEDS_RS = true;
    bf16_t* ACT; const float* part;
    DI void operator()(const f32x4 (&acc)[2][2][4][2], const UnitD& u, int wr, int wc, int fr, int fq, const float (&rs)[2][4]) const {
        const int row0 = u.pm * BM + wr * 64 + fr, col0 = u.pn * HALF + wc * 32 + 8 * fq;
#pragma unroll
        for (int ai = 0; ai < 2; ++ai)
#pragma unroll
            for (int m = 0; m < 4; ++m) { const int row = row0 + ai * HALF + m * 16; const float r_ = rs[ai][m]; float o[8];
#pragma unroll
                for (int n = 0; n < 2; ++n) { const f32x4 g = acc[ai][0][m][n] * r_, uu = acc[ai][1][m][n] * r_;
#pragma unroll
                    for (int e = 0; e < 4; ++e) o[4 * n + e] = g[e] * sigmoidf_(g[e]) * uu[e]; }
                *(u32x4*)(ACT + (size_t)(row >> 8) * ((size_t)PMP * 256) + (size_t)(row & 255) * DFF + col0) = pack8(o); }
    }
};
}

DI void transpose_item(const float* W, int N, int Kd, const float* kscale, bf16_t* WT, int k0, int n0, int drow0, LAS float* scr, int lane) {
    const int kq = lane >> 4, nq = (lane & 15) * 4;
    f32x4 v[16];
#pragma unroll
    for (int i = 0; i < 16; ++i) v[i] = __builtin_nontemporal_load((const f32x4*)(W + (size_t)(k0 + 4 * i + kq) * N + n0 + nq));
#pragma unroll
    for (int i = 0; i < 16; ++i) { const int kk = 4 * i + kq; const float sc = kscale ? kscale[k0 + kk] : 1.0f; LAS float* d = scr + kk * 65 + nq;
        d[0] = v[i][0] * sc; d[1] = v[i][1] * sc; d[2] = v[i][2] * sc; d[3] = v[i][3] * sc; }
    asm volatile("s_waitcnt lgkmcnt(0)" ::: "memory");
    const int c = lane & 7;
#pragma unroll
    for (int j = 0; j < 8; ++j) { const int n = (lane >> 3) + 8 * j; const LAS float* s_ = scr + (8 * c) * 65 + n;
        u32x4 o; o.x = cvt_pk_bf16(s_[0 * 65], s_[1 * 65]); o.y = cvt_pk_bf16(s_[2 * 65], s_[3 * 65]); o.z = cvt_pk_bf16(s_[4 * 65], s_[5 * 65]); o.w = cvt_pk_bf16(s_[6 * 65], s_[7 * 65]);
        *(u32x4*)(WT + (size_t)(drow0 + n) * Kd + k0 + 8 * c) = o; }
    asm volatile("s_waitcnt lgkmcnt(0)" ::: "memory");
}

struct Params {
    const float* x; const float* mix_g; const float* w_in; const float* b_gate; const float* conv_w; const float* conv_b;
    const float* ln_g; const float* ln_b; const float* sgu_w; const float* sgu_b; const float* qg; const float* kg;
    const float* w_bo; const float* w_o; const float* ffn_g; const float* w_gu; const float* w_dn;
    float* out; unsigned char* ws; int ph_lo, ph_hi;
};

constexpr int I_MAIN = 16 * 64, I_IN = 16 * 112, I_BO = 3 * 8 * 16, I_O = 16 * 16, I_GU = 16 * 88, I_DN = 44 * 16, I_REST = I_BO + I_O + I_GU + I_DN;
DI int win_row(int nb) { if (nb >= 8 && nb < 16) { const int cc = 64 * nb - 512; return 512 + 256 * (cc / 128) + (cc % 128); } if (nb >= 16 && nb < 24) { const int cc = 64 * nb - 1024; return 512 + 256 * (cc / 128) + 128 + (cc % 128); } return 64 * nb; }
DI void convert_items(const Params& p, LAS unsigned char* lds, int first, int count) {
    int tid_ = threadIdx.x; asm volatile("" : "+v"(tid_)); const int tid = tid_, lane = tid & 63, wave = tid >> 6;
    LAS float* scr = (LAS float*)(lds + wave * 16640);
    const int gw = blockIdx.x * 8 + wave, NGW = gridDim.x * 8;
    for (int it = first + gw; it < first + count; it += NGW) {
        if (it < 2 * I_IN) { int l, kb, nb;
            if (it < I_MAIN) { l = 0; kb = it / 64; nb = it % 64; }
            else if (it < I_IN) { const int r = it - I_MAIN; l = 0; kb = r / 48; nb = 64 + r % 48; }
            else { const int r = it - I_IN; l = 1; kb = r / 112; nb = r % 112; }
            unsigned char* wl = p.ws + (size_t)l * WS_WL;
            transpose_item(p.w_in + (size_t)l * D_ * NIN, NIN, 1024, p.mix_g + l * D_, (bf16_t*)(wl + W_IN), 64 * kb, 64 * nb, win_row(nb), scr, lane); continue; }
        const int q = it - 2 * I_IN, l = q / I_REST; int r = q - l * I_REST; unsigned char* wl = p.ws + (size_t)l * WS_WL;
        if (r < I_BO) { const int i = r / 128, rr = r % 128, kb = rr / 16, nb = rr % 16; transpose_item(p.w_bo + ((size_t)l * 3 + i) * 512 * 1024, 1024, 512, nullptr, (bf16_t*)(wl + W_BO) + (size_t)i * 1024 * 512, 64 * kb, 64 * nb, 64 * nb, scr, lane); continue; } r -= I_BO;
        if (r < I_O) { const int kb = r / 16, nb = r % 16; transpose_item(p.w_o + (size_t)l * 1024 * 1024, 1024, 1024, nullptr, (bf16_t*)(wl + W_O), 64 * kb, 64 * nb, 64 * nb, scr, lane); continue; } r -= I_O;
        if (r < I_GU) { const int kb = r / 88, nb = r % 88, n0 = 64 * nb, cc = n0 < DFF ? n0 : n0 - DFF, dr = 256 * (cc / 128) + (cc % 128) + (n0 < DFF ? 0 : 128);
            transpose_item(p.w_gu + (size_t)l * 1024 * NGU, NGU, 1024, p.ffn_g + l * D_, (bf16_t*)(wl + W_GU), 64 * kb, n0, dr, scr, lane); continue; } r -= I_GU;
        { const int kb = r / 16, nb = r % 16; transpose_item(p.w_dn + (size_t)l * DFF * 1024, 1024, DFF, nullptr, (bf16_t*)(wl + W_DN), 64 * kb, 64 * nb, 64 * nb, scr, lane); }
    }
}
DI void phase0(const Params& p, LAS unsigned char* lds, int mode, int row_base) {
    int tid_ = threadIdx.x; asm volatile("" : "+v"(tid_)); const int tid = tid_, lane = tid & 63, wave = tid >> 6;
    const int gw = blockIdx.x * 8 + wave, NGW = gridDim.x * 8;
    if (mode != 2) {
    convert_items(p, lds, 0, I_MAIN);
    for (int i = blockIdx.x * 512 + tid; i < 2 * 4 * 128 * 128; i += gridDim.x * 512) {
        const int l = i >> 16, rem = i & 65535, t = (rem >> 7) & 127, s = rem & 127; const float w = p.sgu_w[i];
        ((bf16_t*)(p.ws + (size_t)l * WS_WL + W_SG))[rem] = f2bf(s <= t ? w : 0.f);
    }
    }
    if (mode == 0) return;
    bf16_t* XB = (bf16_t*)(p.ws + WS_XB); float* part = (float*)(p.ws + WS_PART);
    const int mfirst = (mode == 2) ? row_base + wave * 8 : gw, mstep = (mode == 2) ? 1 : NGW, mend = (mode == 2) ? row_base + wave * 8 + 8 : T_;
    for (int m0 = mfirst; m0 < mend; m0 += 4 * mstep) {
        f32x4 v[4][4];
#pragma unroll
        for (int q = 0; q < 4; ++q) { const int m = m0 + q * mstep; const f32x4* xr = (const f32x4*)(p.x + (size_t)(m < mend ? m : m0) * D_) + lane;
#pragma unroll
            for (int j = 0; j < 4; ++j) v[q][j] = xr[64 * j]; }
#pragma unroll
        for (int q = 0; q < 4; ++q) { const int m = m0 + q * mstep; if (m < mend) { float ss = 0.f; u32x2* o8 = (u32x2*)(XB + (size_t)m * D_) + lane;
#pragma unroll
            for (int j = 0; j < 4; ++j) { const f32x4 w_ = v[q][j]; ss += (w_[0] * w_[0] + w_[1] * w_[1]) + (w_[2] * w_[2] + w_[3] * w_[3]); u32x2 w; w.x = cvt_pk_bf16(w_[0], w_[1]); w.y = cvt_pk_bf16(w_[2], w_[3]); o8[64 * j] = w; }
            ss = wave_sum(ss);
            if (lane < 16) part[(size_t)m * 16 + lane] = lane == 0 ? ss : 0.f; } }
    }
}

DI int crow(int r, int hi) { return (r & 3) + 8 * (r >> 2) + 4 * hi; }

constexpr int AT_K = 0, AT_V = 8192, AT_BUF = 16384, AT_FLAG = 32768, AT_OST = 32768 + 256;
DI void pv_acc(f32x16& o0, f32x16& o1, int vb, bf16x8 pa0, bf16x8 pa1, bf16x8 pa2, bf16x8 pa3) {
#pragma unroll
    for (int d0 = 0; d0 < 2; ++d0) { s16x4 lo[4], hi[4];
#pragma unroll
        for (int ks = 0; ks < 4; ++ks) {
            asm volatile("ds_read_b64_tr_b16 %0,%1 offset:%c2" : "=&v"(lo[ks]) : "v"(vb), "i"(d0 * 4096 + ks * 1024) : "memory");
            asm volatile("ds_read_b64_tr_b16 %0,%1 offset:%c2" : "=&v"(hi[ks]) : "v"(vb), "i"(d0 * 4096 + ks * 1024 + 512) : "memory"); }
        asm volatile("s_waitcnt lgkmcnt(0)" ::: "memory"); __builtin_amdgcn_sched_barrier(0);
#define PK(k) (bf16x8){lo[k][0], lo[k][1], lo[k][2], lo[k][3], hi[k][0], hi[k][1], hi[k][2], hi[k][3]}
        f32x16 o = d0 ? o1 : o0;
        o = __builtin_amdgcn_mfma_f32_32x32x16_bf16(pa0, PK(0), o, 0, 0, 0);
        o = __builtin_amdgcn_mfma_f32_32x32x16_bf16(pa1, PK(1), o, 0, 0, 0);
        o = __builtin_amdgcn_mfma_f32_32x32x16_bf16(pa2, PK(2), o, 0, 0, 0);
        o = __builtin_amdgcn_mfma_f32_32x32x16_bf16(pa3, PK(3), o, 0, 0, 0);
        if (d0) o1 = o; else o0 = o;
#undef PK
    }
}

DI void attn_unit(LAS unsigned char* lds, bf16_t* PM, const float* gq, const float* gk, int b, int h, int qb, bf16_t* dmy) {
    int tid_ = threadIdx.x; asm volatile("" : "+v"(tid_)); const int tid = tid_, lane = tid & 63, r32 = lane & 31, hi = lane >> 5, wid = __builtin_amdgcn_readfirstlane(tid >> 6);
    const int q0 = qb * 256; const size_t rowbase = (size_t)b * SEQ_;
    bf16x8 qr[4];
    {
        const bf16_t* Qp = PM + (rowbase + q0 + wid * 32 + r32) * PMP + 2560 + h * 64 + hi * 8;
        float qf[4][8]; float ss = 0.f;
#pragma unroll
        for (int d0 = 0; d0 < 4; ++d0) { unpack8(*(const u32x4*)(Qp + d0 * 16), qf[d0]);
#pragma unroll
            for (int e = 0; e < 8; ++e) ss += qf[d0][e] * qf[d0][e]; }
        ss += __shfl_xor(ss, 32);
        const float sc = C2 / sqrtf(ss * (1.0f / 64.0f) + EPS);
#pragma unroll
        for (int d0 = 0; d0 < 4; ++d0) { float t[8];
#pragma unroll
            for (int e = 0; e < 8; ++e) t[e] = qf[d0][e] * sc * gq[d0 * 16 + hi * 8 + e];
            qr[d0] = __builtin_bit_cast(bf16x8, pack8(t)); }
    }
    const int key = tid >> 3, ch = tid & 7;
    float gkv[8];
#pragma unroll
    for (int e = 0; e < 8; ++e) gkv[e] = gk[ch * 8 + e];
    const bf16_t* kvp = PM + (rowbase + key) * PMP + 3072 + h * 64 + ch * 8;
    LAS unsigned char* kdst = lds + AT_K + ch * 1024 + key * 16;
    LAS unsigned char* vdst = lds + AT_V + ((ch >> 2) * 4 + (key >> 4)) * 1024 + (key & 15) * 64 + (ch & 3) * 16;
    const LAS unsigned char* kb = lds + AT_K + hi * 1024 + r32 * 16;
    const int vb0 = (int)(unsigned)(uintptr_t)(lds + AT_V) + ((lane >> 4) & 1) * 32 + (lane & 3) * 8 + (4 * hi + ((lane & 15) >> 2)) * 64;
    volatile LAS unsigned* flags = (volatile LAS unsigned*)(lds + AT_FLAG);
    const int NT = (q0 + 256) / 64, wq0 = q0 + wid * 32, qi = wq0 + r32;
    float carry = 0.f; f32x16 o0, o1;
#pragma unroll
    for (int r = 0; r < 16; ++r) { o0[r] = 0.f; o1[r] = 0.f; }
    bool wdone = false;
#define AT_STAGE(kr, vr, bsel) do { float kf[8]; unpack8(kr, kf); float ss_ = 0.f; \
        _Pragma("unroll") for (int e = 0; e < 8; ++e) ss_ += kf[e] * kf[e]; \
        ss_ += __shfl_xor(ss_, 1); ss_ += __shfl_xor(ss_, 2); ss_ += __shfl_xor(ss_, 4); \
        const float sc_ = 1.0f / sqrtf(ss_ * (1.0f / 64.0f) + EPS); \
        _Pragma("unroll") for (int e = 0; e < 8; ++e) kf[e] = kf[e] * sc_ * gkv[e]; \
        *(LAS u32x4*)(kdst + (bsel) * AT_BUF) = pack8(kf); *(LAS u32x4*)(vdst + (bsel) * AT_BUF) = vr; } while (0)
    u32x4 kraw = *(const u32x4*)(kvp + (size_t)(NT - 1) * 64 * PMP), vraw = *(const u32x4*)(kvp + (size_t)(NT - 1) * 64 * PMP + 512);
    __syncthreads();
    AT_STAGE(kraw, vraw, (NT - 1) & 1);
    if (NT > 1) { kraw = *(const u32x4*)(kvp + (size_t)(NT - 2) * 64 * PMP); vraw = *(const u32x4*)(kvp + (size_t)(NT - 2) * 64 * PMP + 512); }
    for (int jt = NT - 1; jt >= 0; --jt) {
        __syncthreads();
        if (jt < NT - 1) { unsigned all = 1u;
#pragma unroll
            for (int w = 0; w < 8; ++w) all &= flags[((jt + 1) & 1) * 8 + w];
            if (all) break; }
        if (jt > 0) { AT_STAGE(kraw, vraw, (jt - 1) & 1);
            if (jt > 1) { kraw = *(const u32x4*)(kvp + (size_t)(jt - 2) * 64 * PMP); vraw = *(const u32x4*)(kvp + (size_t)(jt - 2) * 64 * PMP + 512); } }
        const int bo_ = (jt & 1) * AT_BUF;
        const int k0 = jt * 64;
        if (!wdone && k0 <= wq0) {
            f32x16 p0, p1;
#pragma unroll
            for (int r = 0; r < 16; ++r) { p0[r] = 0.f; p1[r] = 0.f; }
#pragma unroll
            for (int d0 = 0; d0 < 4; ++d0) { const bf16x8 b0 = *(const LAS bf16x8*)(kb + bo_ + d0 * 2048), b1 = *(const LAS bf16x8*)(kb + bo_ + d0 * 2048 + 512);
                p0 = __builtin_amdgcn_mfma_f32_32x32x16_bf16(b0, qr[d0], p0, 0, 0, 0); p1 = __builtin_amdgcn_mfma_f32_32x32x16_bf16(b1, qr[d0], p1, 0, 0, 0); }
            const bool needmask = (k0 + 63 >= wq0);
            float Lr[32], lb[32];
            if (needmask) {
#pragma unroll
                for (int i = 0; i < 32; ++i) { const float z = i < 16 ? p0[i] : p1[i - 16]; const int r = i & 15;
                    const float e = __builtin_amdgcn_exp2f(-fabsf(z)); const float sp = fmaxf(z, 0.f) + __builtin_amdgcn_logf(1.0f + e);
                    const bool valid = (k0 + (i >> 4) * 32 + crow(r, hi) < qi);
                    Lr[i] = valid ? -sp : 0.f; lb[i] = valid ? z - sp : -INFINITY; }
            } else {
#pragma unroll
                for (int i = 0; i < 32; ++i) { const float z = i < 16 ? p0[i] : p1[i - 16];
                    const float e = __builtin_amdgcn_exp2f(-fabsf(z)); const float sp = fmaxf(z, 0.f) + __builtin_amdgcn_logf(1.0f + e);
                    Lr[i] = -sp; lb[i] = z - sp; }
            }
            float Tj[8], ex[8];
#pragma unroll
            for (int j = 0; j < 8; ++j) { const float g = (Lr[4 * j] + Lr[4 * j + 1]) + (Lr[4 * j + 2] + Lr[4 * j + 3]);
                auto rr = __builtin_amdgcn_permlane32_swap(__float_as_uint(g), __float_as_uint(g), false, false);
                const float lo = __uint_as_float(rr[0]), hv = __uint_as_float(rr[1]); Tj[j] = lo + hv; ex[j] = hi ? 0.f : hv; }
            float suf = carry; float w[32];
#pragma unroll
            for (int j = 7; j >= 0; --j) { const float a3 = suf + ex[j], a2 = a3 + Lr[4 * j + 3], a1 = a2 + Lr[4 * j + 2], a0 = a1 + Lr[4 * j + 1];
                w[4 * j + 3] = __builtin_amdgcn_exp2f(lb[4 * j + 3] + a3); w[4 * j + 2] = __builtin_amdgcn_exp2f(lb[4 * j + 2] + a2);
                w[4 * j + 1] = __builtin_amdgcn_exp2f(lb[4 * j + 1] + a1); w[4 * j] = __builtin_amdgcn_exp2f(lb[4 * j] + a0);
                suf += Tj[j]; }
            carry = suf;
            wdone = __all(carry < THR2) != 0;
            const bf16x8 pa0 = __builtin_bit_cast(bf16x8, pack8(w)), pa1 = __builtin_bit_cast(bf16x8, pack8(w + 8)), pa2 = __builtin_bit_cast(bf16x8, pack8(w + 16)), pa3 = __builtin_bit_cast(bf16x8, pack8(w + 24));
            pv_acc(o0, o1, vb0 + bo_, pa0, pa1, pa2, pa3);
        }
        if (lane == 0) flags[(jt & 1) * 8 + wid] = wdone ? 1u : 0u;
    }
#undef AT_STAGE
    {
        LAS bf16_t* stg = (LAS bf16_t*)(lds + AT_OST) + wid * 2048;
#pragma unroll
        for (int r = 0; r < 16; ++r) { const int orow = crow(r, hi); stg[orow * 64 + r32] = f2bf(o0[r]); stg[orow * 64 + 32 + r32] = f2bf(o1[r]); }
        asm volatile("s_waitcnt lgkmcnt(0)" ::: "memory");
        bf16_t* Ow = PM + (rowbase + q0 + wid * 32) * PMP + 2560 + h * 64; size_t opitch = PMP;
        if (dmy) { Ow = dmy + (rowbase + q0 + wid * 32) * 512 + h * 64; opitch = 512; }
#pragma unroll
        for (int i = 0; i < 4; ++i) { const int row = i * 8 + (lane >> 3), c8 = lane & 7; const u32x4 v = *(const LAS u32x4*)(stg + row * 64 + c8 * 8); *(u32x4*)(Ow + (size_t)row * opitch + c8 * 8) = v; }
        asm volatile("s_waitcnt lgkmcnt(0)" ::: "memory");
    }
}

DI void sgu_unit(LAS unsigned char* lds, bf16_t* PM, const bf16_t* WsT, const float* lng, const float* lnb, const float* sb, int chunk, int g, bf16_t* dmy) {
    int tid_ = threadIdx.x; asm volatile("" : "+v"(tid_)); const int tid = tid_, lane = tid & 63, r32 = lane & 31, hi = lane >> 5, wid = __builtin_amdgcn_readfirstlane(tid >> 6);
    LAS bf16_t* vT = (LAS bf16_t*)lds;
    LAS float* dstf = (LAS float*)(lds + 36864);
    const size_t tok0 = (size_t)chunk * 128;
    const int tb = wid & 3, chh = wid >> 2;
    const bf16_t* Ap = WsT + (size_t)g * 16384 + (32 * tb + r32) * 128 + 8 * hi;
    bf16x8 Afr[8];
#pragma unroll
    for (int ks = 0; ks < 8; ++ks) { if (ks < 2 * (tb + 1)) Afr[ks] = *(const bf16x8*)(Ap + 16 * ks); else Afr[ks] = (bf16x8){0, 0, 0, 0, 0, 0, 0, 0}; }
    const int er = tid >> 4, ep = tid & 15;
    bf16_t* ubase = PM + (tok0 + er) * PMP + 1536 + 128 * g + 8 * ep;
    u32x4 uraw[4];
#pragma unroll
    for (int i = 0; i < 4; ++i) uraw[i] = *(const u32x4*)(ubase + (size_t)(32 * i) * PMP);
    u32x4 vr[16];
#pragma unroll
    for (int i = 0; i < 16; ++i) vr[i] = *(const u32x4*)(PM + (tok0 + 16 * wid + i) * PMP + 2048 + 8 * lane);
    const int s_ = tid >> 2, qd = tid & 3;
    u32x4 gr[4];
#pragma unroll
    for (int i = 0; i < 4; ++i) gr[i] = *(const u32x4*)(PM + (tok0 + s_) * PMP + 2048 + 128 * g + 32 * qd + 8 * i);
    __syncthreads();
    LAS f32x2* red = (LAS f32x2*)(lds + 36864) + wid * (16 * 65);
#pragma unroll
    for (int i = 0; i < 16; ++i) { float f[8]; unpack8(vr[i], f); float sm = 0.f, sq = 0.f;
#pragma unroll
        for (int e = 0; e < 8; ++e) { sm += f[e]; sq += f[e] * f[e]; }
        red[i * 65 + lane] = (f32x2){sm, sq}; }
    f32x2 mr;
    {
        __builtin_amdgcn_fence(__ATOMIC_RELEASE, "wavefront"); __builtin_amdgcn_wave_barrier(); __builtin_amdgcn_fence(__ATOMIC_ACQUIRE, "wavefront");
        f32x2 ac = {0.f, 0.f}; const LAS f32x2* rp = red + (lane >> 2) * 65 + (lane & 3) * 16;
#pragma unroll
        for (int j = 0; j < 16; ++j) ac += rp[j];
        ac.x += __shfl_xor(ac.x, 1); ac.y += __shfl_xor(ac.y, 1); ac.x += __shfl_xor(ac.x, 2); ac.y += __shfl_xor(ac.y, 2);
        const float mean = ac.x * (1.0f / 512.0f), var = fmaxf(ac.y * (1.0f / 512.0f) - mean * mean, 0.f);
        mr = (f32x2){mean, 1.0f / sqrtf(var + EPS)};
    }
    {
#pragma unroll
        for (int i = 0; i < 4; ++i) { const int c0 = 32 * qd + 8 * i; float f[8]; unpack8(gr[i], f);
            const f32x4 g0 = *(const f32x4*)(lng + 128 * g + c0), g1 = *(const f32x4*)(lng + 128 * g + c0 + 4), b0 = *(const f32x4*)(lnb + 128 * g + c0), b1 = *(const f32x4*)(lnb + 128 * g + c0 + 4);
#pragma unroll
            for (int e = 0; e < 4; ++e) { vT[(c0 + e) * 136 + s_] = f2bf((f[e] - mr.x) * mr.y * g0[e] + b0[e]); vT[(c0 + 4 + e) * 136 + s_] = f2bf((f[4 + e] - mr.x) * mr.y * g1[e] + b1[e]); } }
    }
    __syncthreads();
    f32x16 a0, a1;
#pragma unroll
    for (int r = 0; r < 16; ++r) { a0[r] = 0.f; a1[r] = 0.f; }
    const LAS bf16_t* Bp = vT + (64 * chh + r32) * 136 + 8 * hi;
#pragma unroll
    for (int ks = 0; ks < 8; ++ks) { if (ks < 2 * (tb + 1)) {
        const bf16x8 B0 = *(const LAS bf16x8*)(Bp + 16 * ks), B1 = *(const LAS bf16x8*)(Bp + 32 * 136 + 16 * ks);
        a0 = __builtin_amdgcn_mfma_f32_32x32x16_bf16(Afr[ks], B0, a0, 0, 0, 0); a1 = __builtin_amdgcn_mfma_f32_32x32x16_bf16(Afr[ks], B1, a1, 0, 0, 0); } }
#pragma unroll
    for (int r = 0; r < 16; ++r) { const int t = 32 * tb + crow(r, hi); const float bias = sb[g * 128 + t];
        dstf[t * 132 + 64 * chh + r32] = a0[r] + bias; dstf[t * 132 + 64 * chh + 32 + r32] = a1[r] + bias; }
    __syncthreads();
#pragma unroll
    for (int i = 0; i < 4; ++i) { const int t = er + 32 * i; float u[8], o[8]; unpack8(uraw[i], u);
        const f32x4 m0 = *(const LAS f32x4*)(dstf + t * 132 + 8 * ep), m1 = *(const LAS f32x4*)(dstf + t * 132 + 8 * ep + 4);
#pragma unroll
        for (int e = 0; e < 4; ++e) { o[e] = u[e] * m0[e]; o[4 + e] = u[4 + e] * m1[e]; }
        bf16_t* op = dmy ? dmy + (tok0 + t) * 512 + 128 * g + 8 * ep : ubase + (size_t)(32 * i) * PMP;
        *(u32x4*)op = pack8(o); }
}

DI void conv_unit(bf16_t* PM, const float* cw, const float* cb, int tile, bf16_t* dmy) {
    int tid_ = threadIdx.x; asm volatile("" : "+v"(tid_)); const int tid = tid_, lane = tid & 63, wid = tid >> 6; const int tok_s = tile * 64 + wid * 8, c0 = lane * 8;
    float w0[8], w1[8], w2[8], bb[8], um2[8], um1[8];
#pragma unroll
    for (int e = 0; e < 8; ++e) { w0[e] = cw[c0 + e]; w1[e] = cw[512 + c0 + e]; w2[e] = cw[1024 + c0 + e]; bb[e] = cb[c0 + e]; um2[e] = 0.f; um1[e] = 0.f; }
    const int pos0 = tok_s % SEQ_;
    if (pos0 >= 2) unpack8(*(const u32x4*)(PM + (size_t)(tok_s - 2) * PMP + 512 + c0), um2);
    if (pos0 >= 1) unpack8(*(const u32x4*)(PM + (size_t)(tok_s - 1) * PMP + 512 + c0), um1);
    u32x4 ru[8], rg[8];
#pragma unroll
    for (int t = 0; t < 8; ++t) { const bf16_t* row = PM + (size_t)(tok_s + t) * PMP; ru[t] = *(const u32x4*)(row + 512 + c0); rg[t] = *(const u32x4*)(row + c0); }
#pragma unroll
    for (int t = 0; t < 8; ++t) { bf16_t* row = PM + (size_t)(tok_s + t) * PMP; float uu[8], g[8], o[8];
        unpack8(ru[t], uu); unpack8(rg[t], g);
#pragma unroll
        for (int e = 0; e < 8; ++e) { const float y = bb[e] + w0[e] * um2[e] + w1[e] * um1[e] + w2[e] * uu[e]; o[e] = g[e] * y; um2[e] = um1[e]; um1[e] = uu[e]; }
        *(u32x4*)(dmy ? dmy + (size_t)(tok_s + t) * 512 + c0 : row + c0) = pack8(o); }
}

DI void mixer_phase(const Params& p, LAS unsigned char* lds, int l, bf16_t* dmy) {
    bf16_t* PM = (bf16_t*)(p.ws + WS_BIG);
    const int G = gridDim.x;
    const bool rev = ((blockIdx.x >> 3) & 1) != 0;
    for (int st = 0; st < 4; ++st) {
        const int which = rev ? 3 - st : st;
        if (which == 0) { for (int u = blockIdx.x; u < 512; u += G) attn_unit(lds, PM, p.qg + l * 64, p.kg + l * 64, u >> 8, (u >> 5) & 7, 31 - (u & 31), dmy); }
        else if (which == 1) { for (int u = blockIdx.x; u < 512; u += G) sgu_unit(lds, PM, (const bf16_t*)(p.ws + (size_t)l * WS_WL + W_SG), p.ln_g + l * 512, p.ln_b + l * 512, p.sgu_b + l * 512, u >> 2, u & 3, dmy); }
        else if (which == 2) { for (int u = blockIdx.x; u < 256; u += G) conv_unit(PM, p.conv_w + l * 1536, p.conv_b + l * 512, u, dmy); }
        else if (!dmy) {
            __syncthreads(); if (l == 0) convert_items(p, lds, I_MAIN, 2 * I_IN - I_MAIN + I_REST); else convert_items(p, lds, 2 * I_IN + I_REST, I_REST);
            asm volatile("s_waitcnt lgkmcnt(0)" ::: "memory"); __syncthreads(); }
    }
}


#define XB_TMO      128
#define XB_XCNT(j)  (256  + 64 * (j))
#define XB_XSUB(j)  (1280 + 64 * (j))
#define XB_XGEN(j)  (2304 + 64 * (j))
#define XB_TOP      3328
#define XB_TOPGEN   3392
#define XCD_BAR_WORDS 3456
#define XB_SPIN_CAP (1u << 22)
DI unsigned xb_ld(unsigned* p)              { return __hip_atomic_load(p, __ATOMIC_RELAXED, __HIP_MEMORY_SCOPE_AGENT); }
DI unsigned xb_add(unsigned* p, unsigned v) { return __hip_atomic_fetch_add(p, v, __ATOMIC_RELAXED, __HIP_MEMORY_SCOPE_AGENT); }
DI unsigned xb_xcc_id() { return (unsigned)__builtin_amdgcn_s_getreg((3 << 11) | 20) & 0xFu; }
#define XB_SPIN(cond, bar) do { unsigned _sp = 0; while (cond) { __builtin_amdgcn_s_sleep(1); \
    if ((++_sp & 255u) == 0u) { if (xb_ld(&(bar)[XB_TMO])) break; if (_sp > XB_SPIN_CAP) { atomicAdd(&(bar)[XB_TMO], 1u); break; } } } } while (0)
struct XcdBarrier { unsigned* bar; unsigned x; volatile LAS unsigned* st; };
DI XcdBarrier xcd_barrier_post(unsigned* bar, volatile LAS unsigned* st) {
    XcdBarrier b; b.bar = bar; b.x = xb_xcc_id(); b.st = st;
    if (threadIdx.x == 0) (void)xb_add(&bar[XB_XCNT(b.x)], 1u);
    return b;
}
DI void xcd_barrier_complete(unsigned* bar, unsigned x, unsigned& nloc, unsigned& nx) {
    const unsigned G = gridDim.x * gridDim.y * gridDim.z;
    unsigned sum, cnt, mine, sp = 0u;
    for (;;) {
        sum = 0u; cnt = 0u; mine = 0u;
#pragma unroll
        for (unsigned j = 0; j < 16; ++j) { const unsigned c = xb_ld(&bar[XB_XCNT(j)]); sum += c; cnt += (c > 0u) ? 1u : 0u; mine = (j == x) ? c : mine; }
        if (sum == G) break;
        __builtin_amdgcn_s_sleep(1);
        if ((++sp & 255u) == 0u) { if (xb_ld(&bar[XB_TMO])) break; if (sp > XB_SPIN_CAP) { atomicAdd(&bar[XB_TMO], 1u); break; } }
    }
    nloc = mine > 0u ? mine : 1u; nx = cnt > 0u ? cnt : 1u;
}
DI void xcd_barrier(const XcdBarrier& b) {
    asm volatile("s_waitcnt vmcnt(0)" ::: "memory");
    __syncthreads();
    if (threadIdx.x == 0) {
        unsigned* bar = b.bar;
        __builtin_amdgcn_s_waitcnt(0);
        unsigned nloc = b.st[0], nx = b.st[1];
        if (nloc == 0u) { xcd_barrier_complete(bar, b.x, nloc, nx); b.st[0] = nloc; b.st[1] = nx; }
        const unsigned old = xb_add(&bar[XB_XSUB(b.x)], 1u);
        const unsigned gen = old / nloc;
        if (old + 1u == (gen + 1u) * nloc) {
            __builtin_amdgcn_fence(__ATOMIC_RELEASE, "agent");
            asm volatile("s_waitcnt vmcnt(0)" ::: "memory");
            const unsigned og = xb_add(&bar[XB_TOP], 1u);
            const unsigned tg = og / nx;
            if (og + 1u == (tg + 1u) * nx) xb_add(&bar[XB_TOPGEN], 1u);
            else XB_SPIN(xb_ld(&bar[XB_TOPGEN]) == tg, bar);
            __builtin_amdgcn_fence(__ATOMIC_ACQUIRE, "agent");
            xb_add(&bar[XB_XGEN(b.x)], 1u);
            asm volatile("s_waitcnt vmcnt(0)" ::: "memory");
        } else {
            XB_SPIN(xb_ld(&bar[XB_XGEN(b.x)]) == gen, bar);
            __builtin_amdgcn_fence(__ATOMIC_ACQUIRE, "agent");
            asm volatile("s_waitcnt vmcnt(0)" ::: "memory");
        }
    }
    __syncthreads();
}

DI void panel_barrier(unsigned* cnt, unsigned target, bool same_xcd) {
    asm volatile("s_waitcnt vmcnt(0)" ::: "memory");
    __syncthreads();
    if (threadIdx.x == 0) {
        if (!same_xcd) { __builtin_amdgcn_fence(__ATOMIC_RELEASE, "agent"); asm volatile("s_waitcnt vmcnt(0)" ::: "memory"); }
        (void)xb_add(cnt, 1u);
        unsigned sp = 0;
        while (xb_ld(cnt) < target) { __builtin_amdgcn_s_sleep(1); if (++sp > (1u << 24)) break; }
        __builtin_amdgcn_fence(__ATOMIC_ACQUIRE, "agent"); asm volatile("s_waitcnt vmcnt(0)" ::: "memory");
    }
    __syncthreads();
}

__global__ void __launch_bounds__(512, 2) fwd_kernel(Params p) {
    extern __shared__ __attribute__((aligned(16))) unsigned char lds_raw[];
    LAS unsigned char* lds = (LAS unsigned char*)lds_raw;
    cg::grid_group grid = cg::this_grid();
    const int G = gridDim.x, c = blockIdx.x;
    bf16_t* PM = (bf16_t*)(p.ws + WS_BIG); bf16_t* XB = (bf16_t*)(p.ws + WS_XB); float* part = (float*)(p.ws + WS_PART); float* rsv = (float*)(p.ws + WS_RSV);
    volatile LAS unsigned* MISC = (volatile LAS unsigned*)(lds + 134144);
    if (threadIdx.x < 2) MISC[threadIdx.x] = 0u;
    __syncthreads();
    const XcdBarrier xbar = xcd_barrier_post((unsigned*)(p.ws + WS_BAR), MISC);
    unsigned* pcnt = (unsigned*)(p.ws + WS_BAR + 16384) + 64 * (8 * (c % 8) + ((c >> 3) & 7)); int npanel = 0;
    unsigned* xccs = (unsigned*)(p.ws + WS_XCC); bool same_xcd = false;
    if (threadIdx.x == 0) __hip_atomic_store(xccs + c, xbar.x + 1u, __ATOMIC_RELAXED, __HIP_MEMORY_SCOPE_AGENT);
    if (p.ph_hi > 1000) grid.sync();
    for (int ph = p.ph_lo; ph < p.ph_hi; ++ph) {
#ifndef PHMASK
#define PHMASK 127
#endif
#ifndef DUP_PH
#define DUP_PH -1
#endif
        const int reps = (ph == DUP_PH) ? 2 : 1;
        for (int rep = 0; rep < reps; ++rep) {
        bf16_t* dmy = (reps == 2 && rep == 0) ? (bf16_t*)(p.ws + WS_DMY) : nullptr;
        if (ph == 0) {
            if (G == 256) {
                phase0(p, lds, 0, 0);
                xcd_barrier(xbar);
                { const int c0 = c & 63; unsigned ok = 1u;
#pragma unroll
                    for (int j = 0; j < 4; ++j) ok &= (xb_ld(xccs + c0 + 64 * j) == xbar.x + 1u) ? 1u : 0u;
                    same_xcd = ok != 0u; }
                phase0(p, lds, 2, (8 * (c % 8) + ((c >> 3) & 7)) * 256 + (c >> 6) * 64);
            } else phase0(p, lds, 1, 0);
        }
        else {
            const int l = (ph - 1) / 6, k = (ph - 1) % 6; const unsigned char* wl = p.ws + (size_t)l * WS_WL;
            if (k == 0 && (PHMASK & 2)) {
                pg8::SchedPlain S; S.o.init(T_, NMAIN, G, c); S.A = (const char*)XB; S.B = (const char*)(wl + W_IN); S.lda2 = 2048; S.ldb2 = 2048; S.nt = 16; S.astride = 256 * 2048;
                pg8::EpiMain E{PM, part, rsv}; pg8::gemm_phase(lds, S, E);
            } else if (k == 1 && (PHMASK & 4)) {
                mixer_phase(p, lds, l, dmy);
            } else if (k == 2 && (PHMASK & 8)) {
                pg8::SchedBO S; S.o.init(T_, D_, G, c); S.XB = (const char*)XB; S.PM = (const char*)PM; S.WgT = (const char*)(wl + W_IN) + (size_t)NMAIN * 2048; S.WboT = (const char*)(wl + W_BO);
                pg8::EpiBO E{PM, rsv, p.b_gate + l * 3072}; pg8::gemm_phase(lds, S, E);
            } else if ((k == 3 || k == 5) && (PHMASK & 16)) {
                pg8::SchedPlain S; S.o.init(T_, D_, G, c);
                if (k == 3) { S.A = (const char*)(PM + COL_MG); S.B = (const char*)(wl + W_O); S.lda2 = PMP * 2; S.ldb2 = 2048; S.nt = 16; S.astride = (size_t)256 * PMP * 2; }
                else { S.A = (const char*)PM; S.B = (const char*)(wl + W_DN); S.lda2 = DFF * 2; S.ldb2 = DFF * 2; S.nt = DFF / 64; S.astride = (size_t)256 * PMP * 2; }
                pg8::EpiRes E{(k == 5 && l == 1) ? p.out : nullptr, XB, part}; pg8::gemm_phase(lds, S, E);
            } else if (k == 4 && (PHMASK & 32)) {
                if ((NGU / 256 * 64 - c + G - 1) / G < (NGU / 256 * 64 + G - 1) / G) { for (int i = 0; i < 3; ++i) __builtin_amdgcn_s_sleep(127); }
                pg8::SchedPlain S; S.o.init(T_, NGU, G, c); S.A = (const char*)XB; S.B = (const char*)(wl + W_GU); S.lda2 = 2048; S.ldb2 = 2048; S.nt = 16; S.astride = 256 * 2048;
                pg8::EpiGU E{PM, part}; pg8::gemm_phase(lds, S, E);
            }
        }
        if (rep + 1 < reps) __syncthreads();
        }
        if (ph + 1 < p.ph_hi) {
            const int kk = (ph == 0) ? -1 : (ph - 1) % 6;
            if (G == 256 && (kk >= 2 || ph == 0)) { ++npanel; panel_barrier(pcnt, 4u * (unsigned)npanel, same_xcd); }
            else { xcd_barrier(xbar);
                if (ph == 0 && G == 256) { const int c0 = c & 63; unsigned ok = 1u;
#pragma unroll
                    for (int j = 0; j < 4; ++j) ok &= (xb_ld(xccs + c0 + 64 * j) == xbar.x + 1u) ? 1u : 0u;
                    same_xcd = ok != 0u; } }
        }
    }
}

#ifndef N_LAUNCH_SPLIT
#define N_LAUNCH_SPLIT 0
#endif
extern "C" void kernel_launch(void* const* d_in, const int* in_sizes, int n_in, void* d_out, int out_size, void* d_ws, size_t ws_size, hipStream_t stream) {
    static int grid = 0;
    if (grid == 0) {
        if (n_in != 17 || out_size != T_ * D_ || ws_size < WS_END + 262144) { fprintf(stderr, "kernel_launch: unexpected shapes (n_in %d out %d ws %zu)\n", n_in, out_size, ws_size); grid = -1; return; }
        int dev = 0, cus = 0, per_cu = 0;
        hipGetDevice(&dev); hipDeviceGetAttribute(&cus, hipDeviceAttributeMultiprocessorCount, dev);
        hipFuncSetAttribute((const void*)fwd_kernel, hipFuncAttributeMaxDynamicSharedMemorySize, LDS_BYTES);
        hipOccupancyMaxActiveBlocksPerMultiprocessor(&per_cu, (const void*)fwd_kernel, 512, LDS_BYTES);
        if (per_cu < 1) { fprintf(stderr, "kernel_launch: occupancy query says %d blocks/CU\n", per_cu); per_cu = 1; }
        (void)hipGetLastError();
        grid = cus * 1;
    }
    if (grid < 0) return;
    Params p{};
    p.x = (const float*)d_in[0]; p.mix_g = (const float*)d_in[1]; p.w_in = (const float*)d_in[2]; p.b_gate = (const float*)d_in[3]; p.conv_w = (const float*)d_in[4]; p.conv_b = (const float*)d_in[5];
    p.ln_g = (const float*)d_in[6]; p.ln_b = (const float*)d_in[7]; p.sgu_w = (const float*)d_in[8]; p.sgu_b = (const float*)d_in[9]; p.qg = (const float*)d_in[10]; p.kg = (const float*)d_in[11];
    p.w_bo = (const float*)d_in[12]; p.w_o = (const float*)d_in[13]; p.ffn_g = (const float*)d_in[14]; p.w_gu = (const float*)d_in[15]; p.w_dn = (const float*)d_in[16];
    p.out = (float*)d_out; p.ws = (unsigned char*)d_ws;
#if N_LAUNCH_SPLIT
    for (int ph = 0; ph < 13; ++ph) { p.ph_lo = ph; p.ph_hi = ph + 1; hipLaunchKernelGGL(fwd_kernel, dim3(grid), dim3(512), LDS_BYTES, stream, p); }
#else
    p.ph_lo = 0; p.ph_hi = 13;
    (void)hipMemsetAsync((char*)d_ws + WS_BAR, 0, 32768, stream);
    void* args[] = {&p};
    hipError_t e = hipLaunchCooperativeKernel((const void*)fwd_kernel, dim3(grid), dim3(512), args, LDS_BYTES, stream);
    if (e != hipSuccess) fprintf(stderr, "cooperative launch failed: %s (grid %d)\n", hipGetErrorString(e), grid);
#endif
}
```

```cpp
#include <hip/hip_runtime.h>
#include <hip/hip_cooperative_groups.h>
#include <cstdio>
#include <cstdint>
#include <cmath>
namespace cg = cooperative_groups;

#define LAS __attribute__((address_space(3)))
#define DI __device__ __forceinline__
typedef unsigned short bf16_t;
typedef short bf16x8 __attribute__((ext_vector_type(8)));
typedef float f32x4 __attribute__((ext_vector_type(4)));
typedef float f32x2 __attribute__((ext_vector_type(2)));
typedef float f32x16 __attribute__((ext_vector_type(16)));
typedef unsigned u32x4 __attribute__((ext_vector_type(4)));
typedef unsigned u32x2 __attribute__((ext_vector_type(2)));
typedef short s16x4 __attribute__((ext_vector_type(4)));

constexpr int T_ = 16384, D_ = 1024, SEQ_ = 8192, NMAIN = 4096, NIN = 7168, DFF = 2816, NGU = 5632;
constexpr int PMP = 4096 + 64;
constexpr int COL_GS = 512, COL_MG = 3072;
constexpr float EPS = 1e-6f;
constexpr float C2 = 0.125f * 1.4426950408889634f;
constexpr float THR2 = -150.0f;

constexpr size_t MiB = 1u << 20;
constexpr size_t WS_WL = 36 * MiB;
constexpr size_t W_IN = 0, W_BO = 14 * MiB, W_O = 17 * MiB, W_GU = 19 * MiB, W_DN = 30 * MiB, W_SG = 35 * MiB + 512 * 1024;
constexpr size_t WS_PART = 72 * MiB, WS_XB = 73 * MiB, WS_BIG = 105 * MiB, WS_END = 236 * MiB, WS_BAR = 236 * MiB, WS_RSV = 236 * MiB + 64 * 1024, WS_DMY = 237 * MiB, WS_XCC = 236 * MiB + 192 * 1024;

constexpr int LDS_BYTES = 135168;

typedef __bf16 bf16x2_t __attribute__((ext_vector_type(2)));
DI unsigned cvt_pk_bf16(float lo, float hi) { f32x2 v = {lo, hi}; bf16x2_t b = __builtin_convertvector(v, bf16x2_t); return __builtin_bit_cast(unsigned, b); }
DI float bf_lo(unsigned w) { return __uint_as_float(w << 16); }
DI float bf_hi(unsigned w) { return __uint_as_float(w & 0xffff0000u); }
DI float bf2f(bf16_t v) { return __uint_as_float(((unsigned)v) << 16); }
DI bf16_t f2bf(float f) { return (bf16_t)(cvt_pk_bf16(f, 0.f) & 0xffffu); }
DI void unpack8(const u32x4 w, float* f) { f[0] = bf_lo(w.x); f[1] = bf_hi(w.x); f[2] = bf_lo(w.y); f[3] = bf_hi(w.y); f[4] = bf_lo(w.z); f[5] = bf_hi(w.z); f[6] = bf_lo(w.w); f[7] = bf_hi(w.w); }
DI u32x4 pack8(const float* f) { u32x4 w; w.x = cvt_pk_bf16(f[0], f[1]); w.y = cvt_pk_bf16(f[2], f[3]); w.z = cvt_pk_bf16(f[4], f[5]); w.w = cvt_pk_bf16(f[6], f[7]); return w; }
DI float wave_sum(float v) {
#pragma unroll
    for (int o = 1; o < 64; o <<= 1) v += __shfl_xor(v, o);
    return v;
}
DI float sigmoidf_(float x) { return __builtin_amdgcn_rcpf(1.0f + __builtin_amdgcn_exp2f(-1.4426950408889634f * x)); }
DI f32x2 gelu_pk(f32x2 v) {
    const f32x2 av = __builtin_elementwise_abs(v), d = av * 0.2316418882f + 1.0f;
    f32x2 t; t.x = __builtin_amdgcn_rcpf(d.x); t.y = __builtin_amdgcn_rcpf(d.y);
    f32x2 q = t * 0.5307027145f + (-0.7265760135f); q = q * t + 0.7107068705f; q = q * t + (-0.142248368f); q = q * t + 0.127414796f; q = q * t;
    const f32x2 s = (v * v) * (-0.72134752044f);
    f32x2 e; e.x = __builtin_amdgcn_exp2f(s.x); e.y = __builtin_amdgcn_exp2f(s.y);
    const f32x2 m = v * (q * e), r = v - m;
    f32x2 o; o.x = v.x < 0.f ? m.x : r.x; o.y = v.y < 0.f ? m.y : r.y; return o;
}
DI f32x4 gelu4(f32x4 v) { f32x2 a = gelu_pk((f32x2){v[0], v[1]}), b = gelu_pk((f32x2){v[2], v[3]}); return (f32x4){a.x, a.y, b.x, b.y}; }

namespace pg8 {
constexpr int BM = 256, BK = 64, HALF = 128, HTB = HALF * BK * 2, STAGE_BYTES = 8 * HTB, NXCD = 8, WGM = 8;
DI int lds_byte(int r, int c) { const int st = (r >> 4) * 2 + (c >> 5), rr = r & 15, cc = c & 31, ob = rr * 64 + cc * 2; return st * 1024 + (ob ^ (((ob >> 9) & 1) << 5)); }
DI void stage_rc(int b, int& R, int& C) { const int st = b / 1024, sb = b % 1024, swz = sb ^ (((sb >> 9) & 1) << 5); R = (st >> 1) * 16 + swz / 64; C = (st & 1) * 32 + (swz % 64) / 2; }
DI int perm32(int rho) { const int n = rho >> 4, i = rho & 15; return 8 * (i >> 2) + 4 * n + (i & 3); }

struct UnitD { const char* A; const char* B; unsigned lda2, ldb2; int nt; int pm, pn, aux; };

struct TileOrder {
    int nM, nN, nwg, G, c;
    DI void init(int M, int N, int G_, int c_) { nM = M / BM; nN = N / BM; nwg = nM * nN; G = G_; c = c_; }
    DI bool tile(int i, int& pm, int& pn) const {
        const long L = (long)i * G + c; if (L >= nwg) return false;
        int wgid = (int)L; { const int q = nwg / NXCD, r = nwg % NXCD, xcd = wgid % NXCD, off = wgid / NXCD; wgid = (xcd < r ? xcd * (q + 1) : r * (q + 1) + (xcd - r) * q) + off; }
        const int nig = WGM * nN, gid = wgid / nig, fm = gid * WGM, gsz = (nM - fm) < WGM ? (nM - fm) : WGM;
        pm = fm + ((wgid % nig) % gsz); pn = (wgid % nig) / gsz; return true;
    }
};
struct SchedPlain {
    static constexpr bool UNIFORM_LD = true;
    TileOrder o; const char* A; const char* B; unsigned lda2, ldb2; int nt; size_t astride;
    DI bool get(int i, UnitD& u) const { int pm, pn; if (!o.tile(i, pm, pn)) return false; u.pm = pm; u.pn = pn; u.aux = 0;
        u.A = A + (size_t)pm * astride; u.B = B + (size_t)pn * BM * ldb2; u.lda2 = lda2; u.ldb2 = ldb2; u.nt = nt; return true; }
};
struct SchedBO {
    static constexpr bool UNIFORM_LD = false;
    TileOrder o; const char* XB; const char* PM; const char* WgT; const char* WboT;
    DI bool get(int i, UnitD& u) const { const int ti = i / 6, sub = i - ti * 6, br = sub >> 1; int pm, pn; if (!o.tile(ti, pm, pn)) return false; u.pm = pm; u.pn = pn; u.aux = sub;
        if ((sub & 1) == 0) { u.A = XB + (size_t)pm * BM * 2048; u.lda2 = 2048; u.B = WgT + (size_t)(br * 1024 + pn * BM) * 2048; u.ldb2 = 2048; u.nt = 16; }
        else { const int yc = br == 0 ? 0 : (br == 1 ? 1536 : 2560); u.A = PM + (size_t)pm * BM * (PMP * 2) + yc * 2; u.lda2 = PMP * 2; u.B = WboT + (size_t)(br * 1024 + pn * BM) * 1024; u.ldb2 = 1024; u.nt = 8; }
        return true; }
};

DI void row_rs8(const float* part, int row0, int fq, float (&rs)[2][4]) {
    f32x4 v[2][4];
#pragma unroll
    for (int ai = 0; ai < 2; ++ai)
#pragma unroll
        for (int m = 0; m < 4; ++m) v[ai][m] = *((const f32x4*)(part + (size_t)(row0 + ai * HALF + m * 16) * 16) + fq);
#pragma unroll
    for (int ai = 0; ai < 2; ++ai)
#pragma unroll
        for (int m = 0; m < 4; ++m) { float s_ = (v[ai][m][0] + v[ai][m][1]) + (v[ai][m][2] + v[ai][m][3]); s_ += __shfl_xor(s_, 16); s_ += __shfl_xor(s_, 32); rs[ai][m] = 1.0f / sqrtf(s_ * (1.0f / 1024.0f) + EPS); }
}
template <class Epi, class Sched>
DI void gemm_phase(LAS unsigned char* lds, const Sched& S, const Epi& E) {
    int tid_ = threadIdx.x; asm volatile("" : "+v"(tid_)); const int tid = tid_, wid = __builtin_amdgcn_readfirstlane(tid >> 6), lane = tid & 63, wr = wid >> 2, wc = wid & 3, fr = lane & 15, fq = lane >> 4;
#define PG8_VOFFS(lda_, ldb_, oA0, oA1, oB0, oB1) do { int t2_ = tid; asm volatile("" : "+v"(t2_)); int R0_, C0_, R1_, C1_; stage_rc(t2_ * 16, R0_, C0_); stage_rc(t2_ * 16 + 8192, R1_, C1_); \
        const int Rb0_ = (R0_ & ~31) + perm32(R0_ & 31), Rb1_ = (R1_ & ~31) + perm32(R1_ & 31); \
        oA0 = (unsigned)R0_ * (lda_) + C0_ * 2; oA1 = (unsigned)R1_ * (lda_) + C1_ * 2; oB0 = (unsigned)Rb0_ * (ldb_) + C0_ * 2; oB1 = (unsigned)Rb1_ * (ldb_) + C1_ * 2; } while (0)
    const size_t kstep = (size_t)(BK * 2);
    const unsigned ldsw = (unsigned)wid * 1024u;
    const int aoff = lds_byte(wr * 64 + fr, fq * 8), boff = lds_byte(wc * 32 + fr, fq * 8);
#define PG8_SA(b, h) (((b) * 2 + (h)) * HTB)
#define PG8_SB(b, h) ((4 + (b) * 2 + (h)) * HTB)
#define PG8_STAGE(bufoff, gbase, v0, v1) do { \
        __builtin_amdgcn_global_load_lds((const unsigned*)((const char*)(gbase) + (v0)), (LAS unsigned*)(lds + (bufoff) + ldsw), 16, 0, 0); \
        __builtin_amdgcn_global_load_lds((const unsigned*)((const char*)(gbase) + (v1)), (LAS unsigned*)(lds + (bufoff) + ldsw + 8192), 16, 0, 0); } while (0)
#define PG8_LDA(dst, b, h) do { _Pragma("unroll") for (int m = 0; m < 4; ++m) _Pragma("unroll") for (int k = 0; k < 2; ++k) dst[m][k] = *(const LAS bf16x8*)(lds + PG8_SA(b, h) + aoff + m * 2048 + k * 1024); } while (0)
#define PG8_LDB(dst, b, h) do { _Pragma("unroll") for (int n = 0; n < 2; ++n) _Pragma("unroll") for (int k = 0; k < 2; ++k) dst[n][k] = *(const LAS bf16x8*)(lds + PG8_SB(b, h) + boff + n * 2048 + k * 1024); } while (0)
#define PG8_MMA(ai, bj, At, Bt) do { __builtin_amdgcn_s_setprio(1); _Pragma("unroll") for (int m = 0; m < 4; ++m) _Pragma("unroll") for (int n = 0; n < 2; ++n) _Pragma("unroll") for (int k = 0; k < 2; ++k) \
        acc[ai][bj][m][n] = __builtin_amdgcn_mfma_f32_16x16x32_bf16(Bt[n][k], At[m][k], acc[ai][bj][m][n], 0, 0, 0); __builtin_amdgcn_s_setprio(0); } while (0)
#define PG8_WAIT_V(n) asm volatile("s_waitcnt vmcnt(" #n ")" ::: "memory")
#define PG8_WAIT_L(n) asm volatile("s_waitcnt lgkmcnt(" #n ")" ::: "memory")
#define PG8_BAR __builtin_amdgcn_s_barrier()
#define PG8_SCHED __builtin_amdgcn_sched_barrier(0)
    UnitD cur, nxt; int ui = 0;
    if (!S.get(0, cur)) return;
    float rsc[2][4]; int rs_pm = cur.pm;
    if constexpr (Epi::NEEDS_RS) row_rs8(E.part, cur.pm * BM + wr * 64 + fr, fq, rsc);
    f32x4 acc[2][2][4][2];
#pragma unroll
    for (int a = 0; a < 2; ++a)
#pragma unroll
        for (int b = 0; b < 2; ++b)
#pragma unroll
            for (int m = 0; m < 4; ++m)
#pragma unroll
                for (int n = 0; n < 2; ++n) acc[a][b][m][n] = (f32x4){0.f, 0.f, 0.f, 0.f};
    bf16x8 At[4][2], B0[2][2], B1[2][2];
    const char* cA = cur.A; const char* cB = cur.B;
    unsigned vA0, vA1, vB0, vB1; PG8_VOFFS(cur.lda2, cur.ldb2, vA0, vA1, vB0, vB1);
    size_t hA = (size_t)HALF * cur.lda2, hB = (size_t)HALF * cur.ldb2;
    PG8_STAGE(PG8_SB(0, 0), cB, vB0, vB1); PG8_STAGE(PG8_SB(0, 1), cB + hB, vB0, vB1); PG8_STAGE(PG8_SA(0, 0), cA, vA0, vA1); PG8_STAGE(PG8_SA(0, 1), cA + hA, vA0, vA1);
    if (wr == 1) PG8_BAR;
    PG8_WAIT_V(2); PG8_BAR;
    PG8_STAGE(PG8_SB(1, 0), cB + kstep, vB0, vB1); PG8_STAGE(PG8_SA(1, 0), cA + kstep, vA0, vA1); PG8_STAGE(PG8_SB(1, 1), cB + hB + kstep, vB0, vB1);
    PG8_WAIT_V(6); PG8_BAR;
    for (;;) {
        const bool has_next = S.get(ui + 1, nxt);
        const char* nA = has_next ? nxt.A : cA; const char* nB = has_next ? nxt.B : cB;
        unsigned nvA0 = vA0, nvA1 = vA1, nvB0 = vB0, nvB1 = vB1; size_t nhA = hA, nhB = hB;
        if constexpr (!Sched::UNIFORM_LD) {
            const unsigned nlda = has_next ? nxt.lda2 : cur.lda2, nldb = has_next ? nxt.ldb2 : cur.ldb2;
            PG8_VOFFS(nlda, nldb, nvA0, nvA1, nvB0, nvB1); nhA = (size_t)HALF * nlda; nhB = (size_t)HALF * nldb;
        }
        const int nt = cur.nt;
        for (int t = 0; t < nt; t += 2) {
            const bool last = (t == nt - 2);
            const char* a1 = cA + (size_t)(t + 1) * kstep;
            const char* a2 = last ? nA : cA + (size_t)(t + 2) * kstep; const char* b2 = last ? nB : cB + (size_t)(t + 2) * kstep;
            const char* a3 = a2 + kstep; const char* b3 = b2 + kstep;
            const unsigned xA0 = last ? nvA0 : vA0, xA1 = last ? nvA1 : vA1, xB0 = last ? nvB0 : vB0, xB1 = last ? nvB1 : vB1;
            const size_t xhA = last ? nhA : hA, xhB = last ? nhB : hB;
            PG8_LDB(B0, 0, 0); PG8_LDB(B1, 0, 1); PG8_SCHED; PG8_LDA(At, 0, 0); PG8_STAGE(PG8_SA(1, 1), a1 + hA, vA0, vA1);
            PG8_WAIT_V(8); PG8_WAIT_L(0); PG8_BAR; PG8_MMA(0, 0, At, B0); PG8_MMA(0, 1, At, B1); PG8_BAR; PG8_SCHED;
            PG8_LDA(At, 0, 1); PG8_STAGE(PG8_SB(0, 0), b2, xB0, xB1); PG8_STAGE(PG8_SB(0, 1), b2 + xhB, xB0, xB1); PG8_STAGE(PG8_SA(0, 0), a2, xA0, xA1);
            PG8_WAIT_V(8); PG8_WAIT_L(0); PG8_BAR; PG8_MMA(1, 0, At, B0); PG8_MMA(1, 1, At, B1); PG8_BAR; PG8_SCHED;
            PG8_LDB(B0, 1, 0); PG8_LDB(B1, 1, 1); PG8_SCHED; PG8_LDA(At, 1, 0); PG8_STAGE(PG8_SA(0, 1), a2 + xhA, xA0, xA1);
            PG8_WAIT_V(8); PG8_WAIT_L(0); PG8_BAR; PG8_MMA(0, 0, At, B0); PG8_MMA(0, 1, At, B1); PG8_BAR; PG8_SCHED;
            PG8_LDA(At, 1, 1); PG8_STAGE(PG8_SB(1, 0), b3, xB0, xB1); PG8_STAGE(PG8_SB(1, 1), b3 + xhB, xB0, xB1); PG8_STAGE(PG8_SA(1, 0), a3, xA0, xA1);
            PG8_WAIT_V(8); PG8_WAIT_L(0); PG8_BAR; PG8_MMA(1, 0, At, B0); PG8_MMA(1, 1, At, B1); PG8_BAR; PG8_SCHED;
        }
        if (wr == 0) PG8_BAR;
        if constexpr (Epi::NEEDS_RS) { if (cur.pm != rs_pm) { row_rs8(E.part, cur.pm * BM + wr * 64 + fr, fq, rsc); rs_pm = cur.pm; } E(acc, cur, wr, wc, fr, fq, rsc); }
        else E(acc, cur, wr, wc, fr, fq);
        if (!has_next) break;
#pragma unroll
        for (int a = 0; a < 2; ++a)
#pragma unroll
            for (int b = 0; b < 2; ++b)
#pragma unroll
                for (int m = 0; m < 4; ++m)
#pragma unroll
                    for (int n = 0; n < 2; ++n) acc[a][b][m][n] = (f32x4){0.f, 0.f, 0.f, 0.f};
        cur = nxt; cA = nA; cB = nB; ++ui; vA0 = nvA0; vA1 = nvA1; vB0 = nvB0; vB1 = nvB1; hA = nhA; hB = nhB;
        if (wr == 1) PG8_BAR;
    }
    PG8_WAIT_V(0);
    PG8_BAR;
#undef PG8_VOFFS
#undef PG8_SA
#undef PG8_SB
#undef PG8_STAGE
#undef PG8_LDA
#undef PG8_LDB
#undef PG8_MMA
#undef PG8_WAIT_V
#undef PG8_WAIT_L
#undef PG8_BAR
#undef PG8_SCHED
}

DI u32x4 pk8(const f32x4 v0, const f32x4 v1) { u32x4 w; w.x = cvt_pk_bf16(v0[0], v0[1]); w.y = cvt_pk_bf16(v0[2], v0[3]); w.z = cvt_pk_bf16(v1[0], v1[1]); w.w = cvt_pk_bf16(v1[2], v1[3]); return w; }

struct EpiMain {
    static constexpr bool NEEDS_RS = true;
    bf16_t* PM; const float* part; float* rsv;
    DI void operator()(const f32x4 (&acc)[2][2][4][2], const UnitD& u, int wr, int wc, int fr, int fq, const float (&rs)[2][4]) const {
        const int row0 = u.pm * BM + wr * 64 + fr, col0 = u.pn * BM + wc * 32 + 8 * fq; const bool gl = (u.pn >= 6 && u.pn < 10);
#pragma unroll
        for (int ai = 0; ai < 2; ++ai)
#pragma unroll
            for (int m = 0; m < 4; ++m) { const int row = row0 + ai * HALF + m * 16; const float r_ = rs[ai][m]; bf16_t* rowp = PM + (size_t)row * PMP + col0;
                if (u.pn == 0 && wc == 0 && fq == 0) rsv[row] = r_;
                if (u.pn >= 2 && u.pn < 6) {
                    float o[8];
#pragma unroll
                    for (int n = 0; n < 2; ++n) { const f32x4 cg = acc[ai][0][m][n] * r_, xa = acc[ai][1][m][n] * r_;
#pragma unroll
                        for (int e = 0; e < 4; ++e) o[4 * n + e] = cg[e] * xa[e]; }
                    *(u32x4*)(PM + (size_t)row * PMP + 512 + 128 * (u.pn - 2) + wc * 32 + 8 * fq) = pack8(o);
                } else {
#pragma unroll
                for (int bj = 0; bj < 2; ++bj) { f32x4 v0 = acc[ai][bj][m][0] * r_, v1 = acc[ai][bj][m][1] * r_; if (gl) { v0 = gelu4(v0); v1 = gelu4(v1); }
                    *(u32x4*)(rowp + bj * HALF) = pk8(v0, v1); } } }
    }
};
struct EpiBO {
    static constexpr bool NEEDS_RS = false;
    bf16_t* PM; const float* rsv; const float* bgate;
    DI void operator()(const f32x4 (&acc)[2][2][4][2], const UnitD& u, int wr, int wc, int fr, int fq) const {
        const int row0 = u.pm * BM + wr * 64 + fr, col0 = u.pn * BM + wc * 32 + 8 * fq, br = u.aux >> 1;
        if ((u.aux & 1) == 0) {
            f32x4 bv[2][2]; float rs[2][4];
#pragma unroll
            for (int bj = 0; bj < 2; ++bj)
#pragma unroll
                for (int n = 0; n < 2; ++n) bv[bj][n] = *(const f32x4*)(bgate + br * 1024 + col0 + bj * HALF + 4 * n);
#pragma unroll
            for (int ai = 0; ai < 2; ++ai)
#pragma unroll
                for (int m = 0; m < 4; ++m) rs[ai][m] = rsv[row0 + ai * HALF + m * 16];
#pragma unroll
            for (int ai = 0; ai < 2; ++ai)
#pragma unroll
                for (int m = 0; m < 4; ++m) { const int row = row0 + ai * HALF + m * 16; const float r_ = rs[ai][m];
#pragma unroll
                    for (int bj = 0; bj < 2; ++bj) { f32x4 v0 = acc[ai][bj][m][0] * r_ + bv[bj][0], v1 = acc[ai][bj][m][1] * r_ + bv[bj][1];
                        unsigned q0 = 0u, q1 = 0u;
#pragma unroll
                        for (int e = 0; e < 4; ++e) { q0 |= (unsigned)(sigmoidf_(v0[e]) * 255.0f + 0.5f) << (8 * e); q1 |= (unsigned)(sigmoidf_(v1[e]) * 255.0f + 0.5f) << (8 * e); }
                        *(u32x2*)((unsigned char*)(PM + (size_t)row * PMP + COL_GS) + col0 + bj * HALF) = (u32x2){q0, q1}; } }
        } else {
#pragma unroll
            for (int ai = 0; ai < 2; ++ai) {
                u32x2 gw[4][2]; u32x4 mw[4][2];
#pragma unroll
                for (int m = 0; m < 4; ++m)
#pragma unroll
                    for (int bj = 0; bj < 2; ++bj) { const size_t rr_ = (size_t)(row0 + ai * HALF + m * 16) * PMP, ro = rr_ + col0 + bj * HALF; gw[m][bj] = *(const u32x2*)((const unsigned char*)(PM + rr_ + COL_GS) + col0 + bj * HALF); mw[m][bj] = (br > 0) ? *(const u32x4*)(PM + ro + COL_MG) : (u32x4){0u, 0u, 0u, 0u}; }
#pragma unroll
                for (int m = 0; m < 4; ++m)
#pragma unroll
                    for (int bj = 0; bj < 2; ++bj) { float g[8], o[8], pv_[8]; unpack8(mw[m][bj], pv_);
#pragma unroll
                        for (int e = 0; e < 4; ++e) { g[e] = (float)((gw[m][bj].x >> (8 * e)) & 0xffu) * (1.0f / 255.0f); g[4 + e] = (float)((gw[m][bj].y >> (8 * e)) & 0xffu) * (1.0f / 255.0f); }
                        const f32x4 a0 = acc[ai][bj][m][0], a1 = acc[ai][bj][m][1];
#pragma unroll
                        for (int e = 0; e < 4; ++e) { o[e] = a0[e] * g[e] + pv_[e]; o[4 + e] = a1[e] * g[4 + e] + pv_[4 + e]; }
                        *(u32x4*)(PM + (size_t)(row0 + ai * HALF + m * 16) * PMP + col0 + bj * HALF + COL_MG) = pack8(o); }
                asm volatile("" ::: "memory");
            }
        }
    }
};
struct EpiRes {
    static constexpr bool NEEDS_RS = false;
    float* out; bf16_t* XB; float* part;
    DI void operator()(const f32x4 (&acc)[2][2][4][2], const UnitD& u, int wr, int wc, int fr, int fq) const {
        const int row0 = u.pm * BM + wr * 64 + fr, col0 = u.pn * BM + wc * 32 + 8 * fq;
        u32x4 xw[2][4][2];
#pragma unroll
        for (int ai = 0; ai < 2; ++ai)
#pragma unroll
            for (int m = 0; m < 4; ++m)
#pragma unroll
                for (int bj = 0; bj < 2; ++bj) xw[ai][m][bj] = *(const u32x4*)(XB + (size_t)(row0 + ai * HALF + m * 16) * D_ + col0 + bj * HALF);
#pragma unroll
        for (int ai = 0; ai < 2; ++ai)
#pragma unroll
            for (int m = 0; m < 4; ++m) { const int row = row0 + ai * HALF + m * 16; const size_t off = (size_t)row * D_ + col0; float ss = 0.f;
#pragma unroll
                for (int bj = 0; bj < 2; ++bj) { float b[8]; unpack8(xw[ai][m][bj], b);
                    const f32x4 a0 = acc[ai][bj][m][0], a1 = acc[ai][bj][m][1];
                    const f32x4 x0 = (f32x4){b[0] + a0[0], b[1] + a0[1], b[2] + a0[2], b[3] + a0[3]}, x1 = (f32x4){b[4] + a1[0], b[5] + a1[1], b[6] + a1[2], b[7] + a1[3]};
                    if (out) { *(f32x4*)(out + off + bj * HALF) = x0; *(f32x4*)(out + off + bj * HALF + 4) = x1; }
                    else { *(u32x4*)(XB + off + bj * HALF) = pk8(x0, x1);
                        ss += ((x0[0] * x0[0] + x0[1] * x0[1]) + (x0[2] * x0[2] + x0[3] * x0[3])) + ((x1[0] * x1[0] + x1[1] * x1[1]) + (x1[2] * x1[2] + x1[3] * x1[3])); } }
                if (!out) { ss += __shfl_xor(ss, 16); ss += __shfl_xor(ss, 32);
                    if (fq == 0) part[(size_t)row * 16 + u.pn * 4 + wc] = ss; } }
    }
};
struct EpiGU {
    static constexpr bool NEEDS_RS = true;
    bf16_t* ACT; const float* part;
    DI void operator()(const f32x4 (&acc)[2][2][4][2], const UnitD& u, int wr, int wc, int fr, int fq, const float (&rs)[2][4]) const {
        const int row0 = u.pm * BM + wr * 64 + fr, col0 = u.pn * HALF + wc * 32 + 8 * fq;
#pragma unroll
        for (int ai = 0; ai < 2; ++ai)
#pragma unroll
            for (int m = 0; m < 4; ++m) { const int row = row0 + ai * HALF + m * 16; const float r_ = rs[ai][m]; float o[8];
#pragma unroll
                for (int n = 0; n < 2; ++n) { const f32x4 g = acc[ai][0][m][n] * r_, uu = acc[ai][1][m][n] * r_;
#pragma unroll
                    for (int e = 0; e < 4; ++e) o[4 * n + e] = g[e] * sigmoidf_(g[e]) * uu[e]; }
                *(u32x4*)(ACT + (size_t)(row >> 8) * ((size_t)PMP * 256) + (size_t)(row & 255) * DFF + col0) = pack8(o); }
    }
};
}

DI void transpose_item(const float* W, int N, int Kd, const float* kscale, bf16_t* WT, int k0, int n0, int drow0, LAS float* scr, int lane) {
    const int kq = lane >> 4, nq = (lane & 15) * 4;
    f32x4 v[16];
#pragma unroll
    for (int i = 0; i < 16; ++i) v[i] = __builtin_nontemporal_load((const f32x4*)(W + (size_t)(k0 + 4 * i + kq) * N + n0 + nq));
#pragma unroll
    for (int i = 0; i < 16; ++i) { const int kk = 4 * i + kq; const float sc = kscale ? kscale[k0 + kk] : 1.0f; LAS float* d = scr + kk * 65 + nq;
        d[0] = v[i][0] * sc; d[1] = v[i][1] * sc; d[2] = v[i][2] * sc; d[3] = v[i][3] * sc; }
    asm volatile("s_waitcnt lgkmcnt(0)" ::: "memory");
    const int c = lane & 7;
#pragma unroll
    for (int j = 0; j < 8; ++j) { const int n = (lane >> 3) + 8 * j; const LAS float* s_ = scr + (8 * c) * 65 + n;
        u32x4 o; o.x = cvt_pk_bf16(s_[0 * 65], s_[1 * 65]); o.y = cvt_pk_bf16(s_[2 * 65], s_[3 * 65]); o.z = cvt_pk_bf16(s_[4 * 65], s_[5 * 65]); o.w = cvt_pk_bf16(s_[6 * 65], s_[7 * 65]);
        *(u32x4*)(WT + (size_t)(drow0 + n) * Kd + k0 + 8 * c) = o; }
    asm volatile("s_waitcnt lgkmcnt(0)" ::: "memory");
}

struct Params {
    const float* x; const float* mix_g; const float* w_in; const float* b_gate; const float* conv_w; const float* conv_b;
    const float* ln_g; const float* ln_b; const float* sgu_w; const float* sgu_b; const float* qg; const float* kg;
    const float* w_bo; const float* w_o; const float* ffn_g; const float* w_gu; const float* w_dn;
    float* out; unsigned char* ws; int ph_lo, ph_hi;
};

constexpr int I_MAIN = 16 * 64, I_IN = 16 * 112, I_BO = 3 * 8 * 16, I_O = 16 * 16, I_GU = 16 * 88, I_DN = 44 * 16, I_REST = I_BO + I_O + I_GU + I_DN;
DI int win_row(int nb) { if (nb >= 8 && nb < 16) { const int cc = 64 * nb - 512; return 512 + 256 * (cc / 128) + (cc % 128); } if (nb >= 16 && nb < 24) { const int cc = 64 * nb - 1024; return 512 + 256 * (cc / 128) + 128 + (cc % 128); } return 64 * nb; }
DI void convert_items(const Params& p, LAS unsigned char* lds, int first, int count) {
    int tid_ = threadIdx.x; asm volatile("" : "+v"(tid_)); const int tid = tid_, lane = tid & 63, wave = tid >> 6;
    LAS float* scr = (LAS float*)(lds + wave * 16640);
    const int gw = blockIdx.x * 8 + wave, NGW = gridDim.x * 8;
    for (int it = first + gw; it < first + count; it += NGW) {
        if (it < 2 * I_IN) { int l, kb, nb;
            if (it < I_MAIN) { l = 0; kb = it / 64; nb = it % 64; }
            else if (it < I_IN) { const int r = it - I_MAIN; l = 0; kb = r / 48; nb = 64 + r % 48; }
            else { const int r = it - I_IN; l = 1; kb = r / 112; nb = r % 112; }
            unsigned char* wl = p.ws + (size_t)l * WS_WL;
            transpose_item(p.w_in + (size_t)l * D_ * NIN, NIN, 1024, p.mix_g + l * D_, (bf16_t*)(wl + W_IN), 64 * kb, 64 * nb, win_row(nb), scr, lane); continue; }
        const int q = it - 2 * I_IN, l = q / I_REST; int r = q - l * I_REST; unsigned char* wl = p.ws + (size_t)l * WS_WL;
        if (r < I_BO) { const int i = r / 128, rr = r % 128, kb = rr / 16, nb = rr % 16; transpose_item(p.w_bo + ((size_t)l * 3 + i) * 512 * 1024, 1024, 512, nullptr, (bf16_t*)(wl + W_BO) + (size_t)i * 1024 * 512, 64 * kb, 64 * nb, 64 * nb, scr, lane); continue; } r -= I_BO;
        if (r < I_O) { const int kb = r / 16, nb = r % 16; transpose_item(p.w_o + (size_t)l * 1024 * 1024, 1024, 1024, nullptr, (bf16_t*)(wl + W_O), 64 * kb, 64 * nb, 64 * nb, scr, lane); continue; } r -= I_O;
        if (r < I_GU) { const int kb = r / 88, nb = r % 88, n0 = 64 * nb, cc = n0 < DFF ? n0 : n0 - DFF, dr = 256 * (cc / 128) + (cc % 128) + (n0 < DFF ? 0 : 128);
            transpose_item(p.w_gu + (size_t)l * 1024 * NGU, NGU, 1024, p.ffn_g + l * D_, (bf16_t*)(wl + W_GU), 64 * kb, n0, dr, scr, lane); continue; } r -= I_GU;
        { const int kb = r / 16, nb = r % 16; transpose_item(p.w_dn + (size_t)l * DFF * 1024, 1024, DFF, nullptr, (bf16_t*)(wl + W_DN), 64 * kb, 64 * nb, 64 * nb, scr, lane); }
    }
}
DI void phase0(const Params& p, LAS unsigned char* lds, int mode, int row_base) {
    int tid_ = threadIdx.x; asm volatile("" : "+v"(tid_)); const int tid = tid_, lane = tid & 63, wave = tid >> 6;
    const int gw = blockIdx.x * 8 + wave, NGW = gridDim.x * 8;
    if (mode != 2) {
    convert_items(p, lds, 0, I_MAIN);
    for (int i = blockIdx.x * 512 + tid; i < 2 * 4 * 128 * 128; i += gridDim.x * 512) {
        const int l = i >> 16, rem = i & 65535, t = (rem >> 7) & 127, s = rem & 127; const float w = p.sgu_w[i];
        ((bf16_t*)(p.ws + (size_t)l * WS_WL + W_SG))[rem] = f2bf(s <= t ? w : 0.f);
    }
    }
    if (mode == 0) return;
    bf16_t* XB = (bf16_t*)(p.ws + WS_XB); float* part = (float*)(p.ws + WS_PART);
    const int mfirst = (mode == 2) ? row_base + wave * 8 : gw, mstep = (mode == 2) ? 1 : NGW, mend = (mode == 2) ? row_base + wave * 8 + 8 : T_;
    for (int m0 = mfirst; m0 < mend; m0 += 4 * mstep) {
        f32x4 v[4][4];
#pragma unroll
        for (int q = 0; q < 4; ++q) { const int m = m0 + q * mstep; const f32x4* xr = (const f32x4*)(p.x + (size_t)(m < mend ? m : m0) * D_) + lane;
#pragma unroll
            for (int j = 0; j < 4; ++j) v[q][j] = __builtin_nontemporal_load(xr + 64 * j); }
#pragma unroll
        for (int q = 0; q < 4; ++q) { const int m = m0 + q * mstep; if (m < mend) { float ss = 0.f; u32x2* o8 = (u32x2*)(XB + (size_t)m * D_) + lane;
#pragma unroll
            for (int j = 0; j < 4; ++j) { const f32x4 w_ = v[q][j]; ss += (w_[0] * w_[0] + w_[1] * w_[1]) + (w_[2] * w_[2] + w_[3] * w_[3]); u32x2 w; w.x = cvt_pk_bf16(w_[0], w_[1]); w.y = cvt_pk_bf16(w_[2], w_[3]); o8[64 * j] = w; }
            ss = wave_sum(ss);
            if (lane < 16) part[(size_t)m * 16 + lane] = lane == 0 ? ss : 0.f; } }
    }
}

DI int crow(int r, int hi) { return (r & 3) + 8 * (r >> 2) + 4 * hi; }

constexpr int AT_K = 0, AT_V = 8192, AT_BUF = 16384, AT_FLAG = 32768, AT_OST = 32768 + 256;
DI void pv_acc(f32x16& o0, f32x16& o1, int vb, bf16x8 pa0, bf16x8 pa1, bf16x8 pa2, bf16x8 pa3) {
#pragma unroll
    for (int d0 = 0; d0 < 2; ++d0) { s16x4 lo[4], hi[4];
#pragma unroll
        for (int ks = 0; ks < 4; ++ks) {
            asm volatile("ds_read_b64_tr_b16 %0,%1 offset:%c2" : "=&v"(lo[ks]) : "v"(vb), "i"(d0 * 4096 + ks * 1024) : "memory");
            asm volatile("ds_read_b64_tr_b16 %0,%1 offset:%c2" : "=&v"(hi[ks]) : "v"(vb), "i"(d0 * 4096 + ks * 1024 + 512) : "memory"); }
        asm volatile("s_waitcnt lgkmcnt(0)" ::: "memory"); __builtin_amdgcn_sched_barrier(0);
#define PK(k) (bf16x8){lo[k][0], lo[k][1], lo[k][2], lo[k][3], hi[k][0], hi[k][1], hi[k][2], hi[k][3]}
        f32x16 o = d0 ? o1 : o0;
        o = __builtin_amdgcn_mfma_f32_32x32x16_bf16(pa0, PK(0), o, 0, 0, 0);
        o = __builtin_amdgcn_mfma_f32_32x32x16_bf16(pa1, PK(1), o, 0, 0, 0);
        o = __builtin_amdgcn_mfma_f32_32x32x16_bf16(pa2, PK(2), o, 0, 0, 0);
        o = __builtin_amdgcn_mfma_f32_32x32x16_bf16(pa3, PK(3), o, 0, 0, 0);
        if (d0) o1 = o; else o0 = o;
#undef PK
    }
}

DI void attn_unit(LAS unsigned char* lds, bf16_t* PM, const float* gq, const float* gk, int b, int h, int qb, bf16_t* dmy) {
    int tid_ = threadIdx.x; asm volatile("" : "+v"(tid_)); const int tid = tid_, lane = tid & 63, r32 = lane & 31, hi = lane >> 5, wid = __builtin_amdgcn_readfirstlane(tid >> 6);
    const int q0 = qb * 256; const size_t rowbase = (size_t)b * SEQ_;
    bf16x8 qr[4];
    {
        const bf16_t* Qp = PM + (rowbase + q0 + wid * 32 + r32) * PMP + 2560 + h * 64 + hi * 8;
        float qf[4][8]; float ss = 0.f;
#pragma unroll
        for (int d0 = 0; d0 < 4; ++d0) { unpack8(*(const u32x4*)(Qp + d0 * 16), qf[d0]);
#pragma unroll
            for (int e = 0; e < 8; ++e) ss += qf[d0][e] * qf[d0][e]; }
        ss += __shfl_xor(ss, 32);
        const float sc = C2 / sqrtf(ss * (1.0f / 64.0f) + EPS);
#pragma unroll
        for (int d0 = 0; d0 < 4; ++d0) { float t[8];
#pragma unroll
            for (int e = 0; e < 8; ++e) t[e] = qf[d0][e] * sc * gq[d0 * 16 + hi * 8 + e];
            qr[d0] = __builtin_bit_cast(bf16x8, pack8(t)); }
    }
    const int key = tid >> 3, ch = tid & 7;
    float gkv[8];
#pragma unroll
    for (int e = 0; e < 8; ++e) gkv[e] = gk[ch * 8 + e];
    const bf16_t* kvp = PM + (rowbase + key) * PMP + 3072 + h * 64 + ch * 8;
    LAS unsigned char* kdst = lds + AT_K + ch * 1024 + key * 16;
    LAS unsigned char* vdst = lds + AT_V + ((ch >> 2) * 4 + (key >> 4)) * 1024 + (key & 15) * 64 + (ch & 3) * 16;
    const LAS unsigned char* kb = lds + AT_K + hi * 1024 + r32 * 16;
    const int vb0 = (int)(unsigned)(uintptr_t)(lds + AT_V) + ((lane >> 4) & 1) * 32 + (lane & 3) * 8 + (4 * hi + ((lane & 15) >> 2)) * 64;
    volatile LAS unsigned* flags = (volatile LAS unsigned*)(lds + AT_FLAG);
    const int NT = (q0 + 256) / 64, wq0 = q0 + wid * 32, qi = wq0 + r32;
    float carry = 0.f; f32x16 o0, o1;
#pragma unroll
    for (int r = 0; r < 16; ++r) { o0[r] = 0.f; o1[r] = 0.f; }
    bool wdone = false;
#define AT_STAGE(kr, vr, bsel) do { float kf[8]; unpack8(kr, kf); float ss_ = 0.f; \
        _Pragma("unroll") for (int e = 0; e < 8; ++e) ss_ += kf[e] * kf[e]; \
        ss_ += __shfl_xor(ss_, 1); ss_ += __shfl_xor(ss_, 2); ss_ += __shfl_xor(ss_, 4); \
        const float sc_ = 1.0f / sqrtf(ss_ * (1.0f / 64.0f) + EPS); \
        _Pragma("unroll") for (int e = 0; e < 8; ++e) kf[e] = kf[e] * sc_ * gkv[e]; \
        *(LAS u32x4*)(kdst + (bsel) * AT_BUF) = pack8(kf); *(LAS u32x4*)(vdst + (bsel) * AT_BUF) = vr; } while (0)
    u32x4 kraw = *(const u32x4*)(kvp + (size_t)(NT - 1) * 64 * PMP), vraw = *(const u32x4*)(kvp + (size_t)(NT - 1) * 64 * PMP + 512);
    __syncthreads();
    AT_STAGE(kraw, vraw, (NT - 1) & 1);
    if (NT > 1) { kraw = *(const u32x4*)(kvp + (size_t)(NT - 2) * 64 * PMP); vraw = *(const u32x4*)(kvp + (size_t)(NT - 2) * 64 * PMP + 512); }
    for (int jt = NT - 1; jt >= 0; --jt) {
        __syncthreads();
        if (jt < NT - 1) { unsigned all = 1u;
#pragma unroll
            for (int w = 0; w < 8; ++w) all &= flags[((jt + 1) & 1) * 8 + w];
            if (all) break; }
        if (jt > 0) { AT_STAGE(kraw, vraw, (jt - 1) & 1);
            if (jt > 1) { kraw = *(const u32x4*)(kvp + (size_t)(jt - 2) * 64 * PMP); vraw = *(const u32x4*)(kvp + (size_t)(jt - 2) * 64 * PMP + 512); } }
        const int bo_ = (jt & 1) * AT_BUF;
        const int k0 = jt * 64;
        if (!wdone && k0 <= wq0) {
            f32x16 p0, p1;
#pragma unroll
            for (int r = 0; r < 16; ++r) { p0[r] = 0.f; p1[r] = 0.f; }
#pragma unroll
            for (int d0 = 0; d0 < 4; ++d0) { const bf16x8 b0 = *(const LAS bf16x8*)(kb + bo_ + d0 * 2048), b1 = *(const LAS bf16x8*)(kb + bo_ + d0 * 2048 + 512);
                p0 = __builtin_amdgcn_mfma_f32_32x32x16_bf16(b0, qr[d0], p0, 0, 0, 0); p1 = __builtin_amdgcn_mfma_f32_32x32x16_bf16(b1, qr[d0], p1, 0, 0, 0); }
            const bool needmask = (k0 + 63 >= wq0);
            float Lr[32], lb[32];
            if (needmask) {
#pragma unroll
                for (int i = 0; i < 32; ++i) { const float z = i < 16 ? p0[i] : p1[i - 16]; const int r = i & 15;
                    const float e = __builtin_amdgcn_exp2f(-fabsf(z)); const float sp = fmaxf(z, 0.f) + __builtin_amdgcn_logf(1.0f + e);
                    const bool valid = (k0 + (i >> 4) * 32 + crow(r, hi) < qi);
                    Lr[i] = valid ? -sp : 0.f; lb[i] = valid ? z - sp : -INFINITY; }
            } else {
#pragma unroll
                for (int i = 0; i < 32; ++i) { const float z = i < 16 ? p0[i] : p1[i - 16];
                    const float e = __builtin_amdgcn_exp2f(-fabsf(z)); const float sp = fmaxf(z, 0.f) + __builtin_amdgcn_logf(1.0f + e);
                    Lr[i] = -sp; lb[i] = z - sp; }
            }
            float Tj[8], ex[8];
#pragma unroll
            for (int j = 0; j < 8; ++j) { const float g = (Lr[4 * j] + Lr[4 * j + 1]) + (Lr[4 * j + 2] + Lr[4 * j + 3]);
                auto rr = __builtin_amdgcn_permlane32_swap(__float_as_uint(g), __float_as_uint(g), false, false);
                const float lo = __uint_as_float(rr[0]), hv = __uint_as_float(rr[1]); Tj[j] = lo + hv; ex[j] = hi ? 0.f : hv; }
            float suf = carry; float w[32];
#pragma unroll
            for (int j = 7; j >= 0; --j) { const float a3 = suf + ex[j], a2 = a3 + Lr[4 * j + 3], a1 = a2 + Lr[4 * j + 2], a0 = a1 + Lr[4 * j + 1];
                w[4 * j + 3] = __builtin_amdgcn_exp2f(lb[4 * j + 3] + a3); w[4 * j + 2] = __builtin_amdgcn_exp2f(lb[4 * j + 2] + a2);
                w[4 * j + 1] = __builtin_amdgcn_exp2f(lb[4 * j + 1] + a1); w[4 * j] = __builtin_amdgcn_exp2f(lb[4 * j] + a0);
                suf += Tj[j]; }
            carry = suf;
            wdone = __all(carry < THR2) != 0;
            const bf16x8 pa0 = __builtin_bit_cast(bf16x8, pack8(w)), pa1 = __builtin_bit_cast(bf16x8, pack8(w + 8)), pa2 = __builtin_bit_cast(bf16x8, pack8(w + 16)), pa3 = __builtin_bit_cast(bf16x8, pack8(w + 24));
            pv_acc(o0, o1, vb0 + bo_, pa0, pa1, pa2, pa3);
        }
        if (lane == 0) flags[(jt & 1) * 8 + wid] = wdone ? 1u : 0u;
    }
#undef AT_STAGE
    {
        LAS bf16_t* stg = (LAS bf16_t*)(lds + AT_OST) + wid * 2048;
#pragma unroll
        for (int r = 0; r < 16; ++r) { const int orow = crow(r, hi); stg[orow * 64 + r32] = f2bf(o0[r]); stg[orow * 64 + 32 + r32] = f2bf(o1[r]); }
        asm volatile("s_waitcnt lgkmcnt(0)" ::: "memory");
        bf16_t* Ow = PM + (rowbase + q0 + wid * 32) * PMP + 2560 + h * 64; size_t opitch = PMP;
        if (dmy) { Ow = dmy + (rowbase + q0 + wid * 32) * 512 + h * 64; opitch = 512; }
#pragma unroll
        for (int i = 0; i < 4; ++i) { const int row = i * 8 + (lane >> 3), c8 = lane & 7; const u32x4 v = *(const LAS u32x4*)(stg + row * 64 + c8 * 8); *(u32x4*)(Ow + (size_t)row * opitch + c8 * 8) = v; }
        asm volatile("s_waitcnt lgkmcnt(0)" ::: "memory");
    }
}

DI void sgu_unit(LAS unsigned char* lds, bf16_t* PM, const bf16_t* WsT, const float* lng, const float* lnb, const float* sb, int chunk, int g, bf16_t* dmy) {
    int tid_ = threadIdx.x; asm volatile("" : "+v"(tid_)); const int tid = tid_, lane = tid & 63, r32 = lane & 31, hi = lane >> 5, wid = __builtin_amdgcn_readfirstlane(tid >> 6);
    LAS bf16_t* vT = (LAS bf16_t*)lds;
    LAS float* dstf = (LAS float*)(lds + 36864);
    const size_t tok0 = (size_t)chunk * 128;
    const int tb = wid & 3, chh = wid >> 2;
    const bf16_t* Ap = WsT + (size_t)g * 16384 + (32 * tb + r32) * 128 + 8 * hi;
    bf16x8 Afr[8];
#pragma unroll
    for (int ks = 0; ks < 8; ++ks) { if (ks < 2 * (tb + 1)) Afr[ks] = *(const bf16x8*)(Ap + 16 * ks); else Afr[ks] = (bf16x8){0, 0, 0, 0, 0, 0, 0, 0}; }
    const int er = tid >> 4, ep = tid & 15;
    bf16_t* ubase = PM + (tok0 + er) * PMP + 1536 + 128 * g + 8 * ep;
    u32x4 uraw[4];
#pragma unroll
    for (int i = 0; i < 4; ++i) uraw[i] = *(const u32x4*)(ubase + (size_t)(32 * i) * PMP);
    u32x4 vr[16];
#pragma unroll
    for (int i = 0; i < 16; ++i) vr[i] = *(const u32x4*)(PM + (tok0 + 16 * wid + i) * PMP + 2048 + 8 * lane);
    const int s_ = tid >> 2, qd = tid & 3;
    u32x4 gr[4];
#pragma unroll
    for (int i = 0; i < 4; ++i) gr[i] = *(const u32x4*)(PM + (tok0 + s_) * PMP + 2048 + 128 * g + 32 * qd + 8 * i);
    __syncthreads();
    LAS f32x2* red = (LAS f32x2*)(lds + 36864) + wid * (16 * 65);
#pragma unroll
    for (int i = 0; i < 16; ++i) { float f[8]; unpack8(vr[i], f); float sm = 0.f, sq = 0.f;
#pragma unroll
        for (int e = 0; e < 8; ++e) { sm += f[e]; sq += f[e] * f[e]; }
        red[i * 65 + lane] = (f32x2){sm, sq}; }
    f32x2 mr;
    {
        __builtin_amdgcn_fence(__ATOMIC_RELEASE, "wavefront"); __builtin_amdgcn_wave_barrier(); __builtin_amdgcn_fence(__ATOMIC_ACQUIRE, "wavefront");
        f32x2 ac = {0.f, 0.f}; const LAS f32x2* rp = red + (lane >> 2) * 65 + (lane & 3) * 16;
#pragma unroll
        for (int j = 0; j < 16; ++j) ac += rp[j];
        ac.x += __shfl_xor(ac.x, 1); ac.y += __shfl_xor(ac.y, 1); ac.x += __shfl_xor(ac.x, 2); ac.y += __shfl_xor(ac.y, 2);
        const float mean = ac.x * (1.0f / 512.0f), var = fmaxf(ac.y * (1.0f / 512.0f) - mean * mean, 0.f);
        mr = (f32x2){mean, 1.0f / sqrtf(var + EPS)};
    }
    {
#pragma unroll
        for (int i = 0; i < 4; ++i) { const int c0 = 32 * qd + 8 * i; float f[8]; unpack8(gr[i], f);
            const f32x4 g0 = *(const f32x4*)(lng + 128 * g + c0), g1 = *(const f32x4*)(lng + 128 * g + c0 + 4), b0 = *(const f32x4*)(lnb + 128 * g + c0), b1 = *(const f32x4*)(lnb + 128 * g + c0 + 4);
#pragma unroll
            for (int e = 0; e < 4; ++e) { vT[(c0 + e) * 136 + s_] = f2bf((f[e] - mr.x) * mr.y * g0[e] + b0[e]); vT[(c0 + 4 + e) * 136 + s_] = f2bf((f[4 + e] - mr.x) * mr.y * g1[e] + b1[e]); } }
    }
    __syncthreads();
    f32x16 a0, a1;
#pragma unroll
    for (int r = 0; r < 16; ++r) { a0[r] = 0.f; a1[r] = 0.f; }
    const LAS bf16_t* Bp = vT + (64 * chh + r32) * 136 + 8 * hi;
#pragma unroll
    for (int ks = 0; ks < 8; ++ks) { if (ks < 2 * (tb + 1)) {
        const bf16x8 B0 = *(const LAS bf16x8*)(Bp + 16 * ks), B1 = *(const LAS bf16x8*)(Bp + 32 * 136 + 16 * ks);
        a0 = __builtin_amdgcn_mfma_f32_32x32x16_bf16(Afr[ks], B0, a0, 0, 0, 0); a1 = __builtin_amdgcn_mfma_f32_32x32x16_bf16(Afr[ks], B1, a1, 0, 0, 0); } }
#pragma unroll
    for (int r = 0; r < 16; ++r) { const int t = 32 * tb + crow(r, hi); const float bias = sb[g * 128 + t];
        dstf[t * 132 + 64 * chh + r32] = a0[r] + bias; dstf[t * 132 + 64 * chh + 32 + r32] = a1[r] + bias; }
    __syncthreads();
#pragma unroll
    for (int i = 0; i < 4; ++i) { const int t = er + 32 * i; float u[8], o[8]; unpack8(uraw[i], u);
        const f32x4 m0 = *(const LAS f32x4*)(dstf + t * 132 + 8 * ep), m1 = *(const LAS f32x4*)(dstf + t * 132 + 8 * ep + 4);
#pragma unroll
        for (int e = 0; e < 4; ++e) { o[e] = u[e] * m0[e]; o[4 + e] = u[4 + e] * m1[e]; }
        bf16_t* op = dmy ? dmy + (tok0 + t) * 512 + 128 * g + 8 * ep : ubase + (size_t)(32 * i) * PMP;
        *(u32x4*)op = pack8(o); }
}

DI void conv_unit(bf16_t* PM, const float* cw, const float* cb, int tile, bf16_t* dmy) {
    int tid_ = threadIdx.x; asm volatile("" : "+v"(tid_)); const int tid = tid_, lane = tid & 63, wid = tid >> 6; const int tok_s = tile * 64 + wid * 8, c0 = lane * 8;
    float w0[8], w1[8], w2[8], bb[8], um2[8], um1[8];
#pragma unroll
    for (int e = 0; e < 8; ++e) { w0[e] = cw[c0 + e]; w1[e] = cw[512 + c0 + e]; w2[e] = cw[1024 + c0 + e]; bb[e] = cb[c0 + e]; um2[e] = 0.f; um1[e] = 0.f; }
    const int pos0 = tok_s % SEQ_;
    if (pos0 >= 2) unpack8(*(const u32x4*)(PM + (size_t)(tok_s - 2) * PMP + 512 + c0), um2);
    if (pos0 >= 1) unpack8(*(const u32x4*)(PM + (size_t)(tok_s - 1) * PMP + 512 + c0), um1);
    u32x4 ru[8], rg[8];
#pragma unroll
    for (int t = 0; t < 8; ++t) { const bf16_t* row = PM + (size_t)(tok_s + t) * PMP; ru[t] = __builtin_nontemporal_load((const u32x4*)(row + 512 + c0)); rg[t] = __builtin_nontemporal_load((const u32x4*)(row + c0)); }
#pragma unroll
    for (int t = 0; t < 8; ++t) { bf16_t* row = PM + (size_t)(tok_s + t) * PMP; float uu[8], g[8], o[8];
        unpack8(ru[t], uu); unpack8(rg[t], g);
#pragma unroll
        for (int e = 0; e < 8; ++e) { const float y = bb[e] + w0[e] * um2[e] + w1[e] * um1[e] + w2[e] * uu[e]; o[e] = g[e] * y; um2[e] = um1[e]; um1[e] = uu[e]; }
        *(u32x4*)(dmy ? dmy + (size_t)(tok_s + t) * 512 + c0 : row + c0) = pack8(o); }
}

DI void mixer_phase(const Params& p, LAS unsigned char* lds, int l, bf16_t* dmy) {
    bf16_t* PM = (bf16_t*)(p.ws + WS_BIG);
    const int G = gridDim.x;
    const bool rev = ((blockIdx.x >> 3) & 1) != 0;
    for (int st = 0; st < 4; ++st) {
        const int which = rev ? 3 - st : st;
        if (which == 0) { for (int u = blockIdx.x; u < 512; u += G) attn_unit(lds, PM, p.qg + l * 64, p.kg + l * 64, u >> 8, (u >> 5) & 7, 31 - (u & 31), dmy); }
        else if (which == 1) { for (int u = blockIdx.x; u < 512; u += G) sgu_unit(lds, PM, (const bf16_t*)(p.ws + (size_t)l * WS_WL + W_SG), p.ln_g + l * 512, p.ln_b + l * 512, p.sgu_b + l * 512, u >> 2, u & 3, dmy); }
        else if (which == 2) { for (int u = blockIdx.x; u < 256; u += G) conv_unit(PM, p.conv_w + l * 1536, p.conv_b + l * 512, u, dmy); }
        else if (!dmy) {
            __syncthreads(); if (l == 0) convert_items(p, lds, I_MAIN, 2 * I_IN - I_MAIN + I_REST); else convert_items(p, lds, 2 * I_IN + I_REST, I_REST);
            asm volatile("s_waitcnt lgkmcnt(0)" ::: "memory"); __syncthreads(); }
    }
}


#define XB_TMO      128
#define XB_XCNT(j)  (256  + 64 * (j))
#define XB_XSUB(j)  (1280 + 64 * (j))
#define XB_XGEN(j)  (2304 + 64 * (j))
#define XB_TOP      3328
#define XB_TOPGEN   3392
#define XCD_BAR_WORDS 3456
#define XB_SPIN_CAP (1u << 22)
DI unsigned xb_ld(unsigned* p)              { return __hip_atomic_load(p, __ATOMIC_RELAXED, __HIP_MEMORY_SCOPE_AGENT); }
DI unsigned xb_add(unsigned* p, unsigned v) { return __hip_atomic_fetch_add(p, v, __ATOMIC_RELAXED, __HIP_MEMORY_SCOPE_AGENT); }
DI unsigned xb_xcc_id() { return (unsigned)__builtin_amdgcn_s_getreg((3 << 11) | 20) & 0xFu; }
#define XB_SPIN(cond, bar) do { unsigned _sp = 0; while (cond) { __builtin_amdgcn_s_sleep(1); \
    if ((++_sp & 255u) == 0u) { if (xb_ld(&(bar)[XB_TMO])) break; if (_sp > XB_SPIN_CAP) { atomicAdd(&(bar)[XB_TMO], 1u); break; } } } } while (0)
struct XcdBarrier { unsigned* bar; unsigned x; volatile LAS unsigned* st; };
DI XcdBarrier xcd_barrier_post(unsigned* bar, volatile LAS unsigned* st) {
    XcdBarrier b; b.bar = bar; b.x = xb_xcc_id(); b.st = st;
    if (threadIdx.x == 0) (void)xb_add(&bar[XB_XCNT(b.x)], 1u);
    return b;
}
DI void xcd_barrier_complete(unsigned* bar, unsigned x, unsigned& nloc, unsigned& nx) {
    const unsigned G = gridDim.x * gridDim.y * gridDim.z;
    unsigned sum, cnt, mine, sp = 0u;
    for (;;) {
        sum = 0u; cnt = 0u; mine = 0u;
#pragma unroll
        for (unsigned j = 0; j < 16; ++j) { const unsigned c = xb_ld(&bar[XB_XCNT(j)]); sum += c; cnt += (c > 0u) ? 1u : 0u; mine = (j == x) ? c : mine; }
        if (sum == G) break;
        __builtin_amdgcn_s_sleep(1);
        if ((++sp & 255u) == 0u) { if (xb_ld(&bar[XB_TMO])) break; if (sp > XB_SPIN_CAP) { atomicAdd(&bar[XB_TMO], 1u); break; } }
    }
    nloc = mine > 0u ? mine : 1u; nx = cnt > 0u ? cnt : 1u;
}
DI void xcd_barrier(const XcdBarrier& b) {
    asm volatile("s_waitcnt vmcnt(0)" ::: "memory");
    __syncthreads();
    if (threadIdx.x == 0) {
        unsigned* bar = b.bar;
        __builtin_amdgcn_s_waitcnt(0);
        unsigned nloc = b.st[0], nx = b.st[1];
        if (nloc == 0u) { xcd_barrier_complete(bar, b.x, nloc, nx); b.st[0] = nloc; b.st[1] = nx; }
        const unsigned old = xb_add(&bar[XB_XSUB(b.x)], 1u);
        const unsigned gen = old / nloc;
        if (old + 1u == (gen + 1u) * nloc) {
            __builtin_amdgcn_fence(__ATOMIC_RELEASE, "agent");
            asm volatile("s_waitcnt vmcnt(0)" ::: "memory");
            const unsigned og = xb_add(&bar[XB_TOP], 1u);
            const unsigned tg = og / nx;
            if (og + 1u == (tg + 1u) * nx) xb_add(&bar[XB_TOPGEN], 1u);
            else XB_SPIN(xb_ld(&bar[XB_TOPGEN]) == tg, bar);
            __builtin_amdgcn_fence(__ATOMIC_ACQUIRE, "agent");
            xb_add(&bar[XB_XGEN(b.x)], 1u);
            asm volatile("s_waitcnt vmcnt(0)" ::: "memory");
        } else {
            XB_SPIN(xb_ld(&bar[XB_XGEN(b.x)]) == gen, bar);
            __builtin_amdgcn_fence(__ATOMIC_ACQUIRE, "agent");
            asm volatile("s_waitcnt vmcnt(0)" ::: "memory");
        }
    }
    __syncthreads();
}

DI void panel_barrier(unsigned* cnt, unsigned target, bool same_xcd) {
    asm volatile("s_waitcnt vmcnt(0)" ::: "memory");
    __syncthreads();
    if (threadIdx.x == 0) {
        if (!same_xcd) { __builtin_amdgcn_fence(__ATOMIC_RELEASE, "agent"); asm volatile("s_waitcnt vmcnt(0)" ::: "memory"); }
        (void)xb_add(cnt, 1u);
        unsigned sp = 0;
        while (xb_ld(cnt) < target) { __builtin_amdgcn_s_sleep(1); if (++sp > (1u << 24)) break; }
        __builtin_amdgcn_fence(__ATOMIC_ACQUIRE, "agent"); asm volatile("s_waitcnt vmcnt(0)" ::: "memory");
    }
    __syncthreads();
}

__global__ void __launch_bounds__(512, 2) fwd_kernel(Params p) {
    extern __shared__ __attribute__((aligned(16))) unsigned char lds_raw[];
    LAS unsigned char* lds = (LAS unsigned char*)lds_raw;
    cg::grid_group grid = cg::this_grid();
    const int G = gridDim.x, c = blockIdx.x;
    bf16_t* PM = (bf16_t*)(p.ws + WS_BIG); bf16_t* XB = (bf16_t*)(p.ws + WS_XB); float* part = (float*)(p.ws + WS_PART); float* rsv = (float*)(p.ws + WS_RSV);
    volatile LAS unsigned* MISC = (volatile LAS unsigned*)(lds + 134144);
    if (threadIdx.x < 2) MISC[threadIdx.x] = 0u;
    __syncthreads();
    const XcdBarrier xbar = xcd_barrier_post((unsigned*)(p.ws + WS_BAR), MISC);
    unsigned* pcnt = (unsigned*)(p.ws + WS_BAR + 16384) + 64 * (8 * (c % 8) + ((c >> 3) & 7)); int npanel = 0;
    unsigned* xccs = (unsigned*)(p.ws + WS_XCC); bool same_xcd = false;
    if (threadIdx.x == 0) __hip_atomic_store(xccs + c, xbar.x + 1u, __ATOMIC_RELAXED, __HIP_MEMORY_SCOPE_AGENT);
    if (p.ph_hi > 1000) grid.sync();
    for (int ph = p.ph_lo; ph < p.ph_hi; ++ph) {
#ifndef PHMASK
#define PHMASK 127
#endif
#ifndef DUP_PH
#define DUP_PH -1
#endif
        const int reps = (ph == DUP_PH) ? 2 : 1;
        for (int rep = 0; rep < reps; ++rep) {
        bf16_t* dmy = (reps == 2 && rep == 0) ? (bf16_t*)(p.ws + WS_DMY) : nullptr;
        if (ph == 0) {
            if (G == 256) {
                phase0(p, lds, 0, 0);
                xcd_barrier(xbar);
                { const int c0 = c & 63; unsigned ok = 1u;
#pragma unroll
                    for (int j = 0; j < 4; ++j) ok &= (xb_ld(xccs + c0 + 64 * j) == xbar.x + 1u) ? 1u : 0u;
                    same_xcd = ok != 0u; }
                phase0(p, lds, 2, (8 * (c % 8) + ((c >> 3) & 7)) * 256 + (c >> 6) * 64);
            } else phase0(p, lds, 1, 0);
        }
        else {
            const int l = (ph - 1) / 6, k = (ph - 1) % 6; const unsigned char* wl = p.ws + (size_t)l * WS_WL;
            if (k == 0 && (PHMASK & 2)) {
                pg8::SchedPlain S; S.o.init(T_, NMAIN, G, c); S.A = (const char*)XB; S.B = (const char*)(wl + W_IN); S.lda2 = 2048; S.ldb2 = 2048; S.nt = 16; S.astride = 256 * 2048;
                pg8::EpiMain E{PM, part, rsv}; pg8::gemm_phase(lds, S, E);
            } else if (k == 1 && (PHMASK & 4)) {
                mixer_phase(p, lds, l, dmy);
            } else if (k == 2 && (PHMASK & 8)) {
                pg8::SchedBO S; S.o.init(T_, D_, G, c); S.XB = (const char*)XB; S.PM = (const char*)PM; S.WgT = (const char*)(wl + W_IN) + (size_t)NMAIN * 2048; S.WboT = (const char*)(wl + W_BO);
                pg8::EpiBO E{PM, rsv, p.b_gate + l * 3072}; pg8::gemm_phase(lds, S, E);
            } else if ((k == 3 || k == 5) && (PHMASK & 16)) {
                pg8::SchedPlain S; S.o.init(T_, D_, G, c);
                if (k == 3) { S.A = (const char*)(PM + COL_MG); S.B = (const char*)(wl + W_O); S.lda2 = PMP * 2; S.ldb2 = 2048; S.nt = 16; S.astride = (size_t)256 * PMP * 2; }
                else { S.A = (const char*)PM; S.B = (const char*)(wl + W_DN); S.lda2 = DFF * 2; S.ldb2 = DFF * 2; S.nt = DFF / 64; S.astride = (size_t)256 * PMP * 2; }
                pg8::EpiRes E{(k == 5 && l == 1) ? p.out : nullptr, XB, part}; pg8::gemm_phase(lds, S, E);
            } else if (k == 4 && (PHMASK & 32)) {
                if ((NGU / 256 * 64 - c + G - 1) / G < (NGU / 256 * 64 + G - 1) / G) { for (int i = 0; i < 3; ++i) __builtin_amdgcn_s_sleep(127); }
                pg8::SchedPlain S; S.o.init(T_, NGU, G, c); S.A = (const char*)XB; S.B = (const char*)(wl + W_GU); S.lda2 = 2048; S.ldb2 = 2048; S.nt = 16; S.astride = 256 * 2048;
                pg8::EpiGU E{PM, part}; pg8::gemm_phase(lds, S, E);
            }
        }
        if (rep + 1 < reps) __syncthreads();
        }
        if (ph + 1 < p.ph_hi) {
            const int kk = (ph == 0) ? -1 : (ph - 1) % 6;
            if (G == 256 && (kk >= 2 || ph == 0)) { ++npanel; panel_barrier(pcnt, 4u * (unsigned)npanel, same_xcd); }
            else { xcd_barrier(xbar);
                if (ph == 0 && G == 256) { const int c0 = c & 63; unsigned ok = 1u;
#pragma unroll
                    for (int j = 0; j < 4; ++j) ok &= (xb_ld(xccs + c0 + 64 * j) == xbar.x + 1u) ? 1u : 0u;
                    same_xcd = ok != 0u; } }
        }
    }
}

#ifndef N_LAUNCH_SPLIT
#define N_LAUNCH_SPLIT 0
#endif
extern "C" void kernel_launch(void* const* d_in, const int* in_sizes, int n_in, void* d_out, int out_size, void* d_ws, size_t ws_size, hipStream_t stream) {
    static int grid = 0;
    if (grid == 0) {
        if (n_in != 17 || out_size != T_ * D_ || ws_size < WS_END + 262144) { fprintf(stderr, "kernel_launch: unexpected shapes (n_in %d out %d ws %zu)\n", n_in, out_size, ws_size); grid = -1; return; }
        int dev = 0, cus = 0, per_cu = 0;
        hipGetDevice(&dev); hipDeviceGetAttribute(&cus, hipDeviceAttributeMultiprocessorCount, dev);
        hipFuncSetAttribute((const void*)fwd_kernel, hipFuncAttributeMaxDynamicSharedMemorySize, LDS_BYTES);
        hipOccupancyMaxActiveBlocksPerMultiprocessor(&per_cu, (const void*)fwd_kernel, 512, LDS_BYTES);
        if (per_cu < 1) { fprintf(stderr, "kernel_launch: occupancy query says %d blocks/CU\n", per_cu); per_cu = 1; }
        (void)hipGetLastError();
        grid = cus * 1;
    }
    if (grid < 0) return;
    Params p{};
    p.x = (const float*)d_in[0]; p.mix_g = (const float*)d_in[1]; p.w_in = (const float*)d_in[2]; p.b_gate = (const float*)d_in[3]; p.conv_w = (const float*)d_in[4]; p.conv_b = (const float*)d_in[5];
    p.ln_g = (const float*)d_in[6]; p.ln_b = (const float*)d_in[7]; p.sgu_w = (const float*)d_in[8]; p.sgu_b = (const float*)d_in[9]; p.qg = (const float*)d_in[10]; p.kg = (const float*)d_in[11];
    p.w_bo = (const float*)d_in[12]; p.w_o = (const float*)d_in[13]; p.ffn_g = (const float*)d_in[14]; p.w_gu = (const float*)d_in[15]; p.w_dn = (const float*)d_in[16];
    p.out = (float*)d_out; p.ws = (unsigned char*)d_ws;
#if N_LAUNCH_SPLIT
    for (int ph = 0; ph < 13; ++ph) { p.ph_lo = ph; p.ph_hi = ph + 1; hipLaunchKernelGGL(fwd_kernel, dim3(grid), dim3(512), LDS_BYTES, stream, p); }
#else
    p.ph_lo = 0; p.ph_hi = 13;
    (void)hipMemsetAsync((char*)d_ws + WS_BAR, 0, 32768, stream);
    void* args[] = {&p};
    hipError_t e = hipLaunchCooperativeKernel((const void*)fwd_kernel, dim3(grid), dim3(512), args, LDS_BYTES, stream);
    if (e != hipSuccess) fprintf(stderr, "cooperative launch failed: %s (grid %d)\n", hipGetErrorString(e), grid);
#endif
}
```

```cpp
#include <hip/hip_runtime.h>
#include <hip/hip_cooperative_groups.h>
#include <cstdio>
#include <cstdint>
#include <cmath>
namespace cg = cooperative_groups;

#define LAS __attribute__((address_space(3)))
#define DI __device__ __forceinline__
typedef unsigned short bf16_t;
typedef short bf16x8 __attribute__((ext_vector_type(8)));
typedef float f32x4 __attribute__((ext_vector_type(4)));
typedef float f32x2 __attribute__((ext_vector_type(2)));
typedef float f32x16 __attribute__((ext_vector_type(16)));
typedef unsigned u32x4 __attribute__((ext_vector_type(4)));
typedef unsigned u32x2 __attribute__((ext_vector_type(2)));
typedef short s16x4 __attribute__((ext_vector_type(4)));

constexpr int T_ = 16384, D_ = 1024, SEQ_ = 8192, NMAIN = 4096, NIN = 7168, DFF = 2816, NGU = 5632;
constexpr int PMP = 4096 + 64;
constexpr int COL_GS = 512, COL_MG = 3072;
constexpr float EPS = 1e-6f;
constexpr float C2 = 0.125f * 1.4426950408889634f;
constexpr float THR2 = -150.0f;

constexpr size_t MiB = 1u << 20;
constexpr size_t WS_WL = 36 * MiB;
constexpr size_t W_IN = 0, W_BO = 14 * MiB, W_O = 17 * MiB, W_GU = 19 * MiB, W_DN = 30 * MiB, W_SG = 35 * MiB + 512 * 1024;
constexpr size_t WS_PART = 72 * MiB, WS_XB = 73 * MiB, WS_BIG = 105 * MiB, WS_END = 236 * MiB, WS_BAR = 236 * MiB, WS_RSV = 236 * MiB + 64 * 1024, WS_DMY = 237 * MiB, WS_XCC = 236 * MiB + 192 * 1024;

constexpr int LDS_BYTES = 135168;

typedef __bf16 bf16x2_t __attribute__((ext_vector_type(2)));
DI unsigned cvt_pk_bf16(float lo, float hi) { f32x2 v = {lo, hi}; bf16x2_t b = __builtin_convertvector(v, bf16x2_t); return __builtin_bit_cast(unsigned, b); }
DI float bf_lo(unsigned w) { return __uint_as_float(w << 16); }
DI float bf_hi(unsigned w) { return __uint_as_float(w & 0xffff0000u); }
DI float bf2f(bf16_t v) { return __uint_as_float(((unsigned)v) << 16); }
DI bf16_t f2bf(float f) { return (bf16_t)(cvt_pk_bf16(f, 0.f) & 0xffffu); }
DI void unpack8(const u32x4 w, float* f) { f[0] = bf_lo(w.x); f[1] = bf_hi(w.x); f[2] = bf_lo(w.y); f[3] = bf_hi(w.y); f[4] = bf_lo(w.z); f[5] = bf_hi(w.z); f[6] = bf_lo(w.w); f[7] = bf_hi(w.w); }
DI u32x4 pack8(const float* f) { u32x4 w; w.x = cvt_pk_bf16(f[0], f[1]); w.y = cvt_pk_bf16(f[2], f[3]); w.z = cvt_pk_bf16(f[4], f[5]); w.w = cvt_pk_bf16(f[6], f[7]); return w; }
DI float wave_sum(float v) {
#pragma unroll
    for (int o = 1; o < 64; o <<= 1) v += __shfl_xor(v, o);
    return v;
}
DI float sigmoidf_(float x) { return __builtin_amdgcn_rcpf(1.0f + __builtin_amdgcn_exp2f(-1.4426950408889634f * x)); }
DI f32x2 gelu_pk(f32x2 v) {
    const f32x2 av = __builtin_elementwise_abs(v), d = av * 0.2316418882f + 1.0f;
    f32x2 t; t.x = __builtin_amdgcn_rcpf(d.x); t.y = __builtin_amdgcn_rcpf(d.y);
    f32x2 q = t * 0.5307027145f + (-0.7265760135f); q = q * t + 0.7107068705f; q = q * t + (-0.142248368f); q = q * t + 0.127414796f; q = q * t;
    const f32x2 s = (v * v) * (-0.72134752044f);
    f32x2 e; e.x = __builtin_amdgcn_exp2f(s.x); e.y = __builtin_amdgcn_exp2f(s.y);
    const f32x2 m = v * (q * e), r = v - m;
    f32x2 o; o.x = v.x < 0.f ? m.x : r.x; o.y = v.y < 0.f ? m.y : r.y; return o;
}
DI f32x4 gelu4(f32x4 v) { f32x2 a = gelu_pk((f32x2){v[0], v[1]}), b = gelu_pk((f32x2){v[2], v[3]}); return (f32x4){a.x, a.y, b.x, b.y}; }

namespace pg8 {
constexpr int BM = 256, BK = 64, HALF = 128, HTB = HALF * BK * 2, STAGE_BYTES = 8 * HTB, NXCD = 8, WGM = 8;
DI int lds_byte(int r, int c) { const int st = (r >> 4) * 2 + (c >> 5), rr = r & 15, cc = c & 31, ob = rr * 64 + cc * 2; return st * 1024 + (ob ^ (((ob >> 9) & 1) << 5)); }
DI void stage_rc(int b, int& R, int& C) { const int st = b / 1024, sb = b % 1024, swz = sb ^ (((sb >> 9) & 1) << 5); R = (st >> 1) * 16 + swz / 64; C = (st & 1) * 32 + (swz % 64) / 2; }
DI int perm32(int rho) { const int n = rho >> 4, i = rho & 15; return 8 * (i >> 2) + 4 * n + (i & 3); }

struct UnitD { const char* A; const char* B; unsigned lda2, ldb2; int nt; int pm, pn, aux; };

struct TileOrder {
    int nM, nN, nwg, G, c;
    DI void init(int M, int N, int G_, int c_) { nM = M / BM; nN = N / BM; nwg = nM * nN; G = G_; c = c_; }
    DI bool tile(int i, int& pm, int& pn) const {
        const long L = (long)i * G + c; if (L >= nwg) return false;
        int wgid = (int)L; { const int q = nwg / NXCD, r = nwg % NXCD, xcd = wgid % NXCD, off = wgid / NXCD; wgid = (xcd < r ? xcd * (q + 1) : r * (q + 1) + (xcd - r) * q) + off; }
        const int nig = WGM * nN, gid = wgid / nig, fm = gid * WGM, gsz = (nM - fm) < WGM ? (nM - fm) : WGM;
        pm = fm + ((wgid % nig) % gsz); pn = (wgid % nig) / gsz; return true;
    }
};
struct SchedPlain {
    static constexpr bool UNIFORM_LD = true;
    TileOrder o; const char* A; const char* B; unsigned lda2, ldb2; int nt; size_t astride;
    DI bool get(int i, UnitD& u) const { int pm, pn; if (!o.tile(i, pm, pn)) return false; u.pm = pm; u.pn = pn; u.aux = 0;
        u.A = A + (size_t)pm * astride; u.B = B + (size_t)pn * BM * ldb2; u.lda2 = lda2; u.ldb2 = ldb2; u.nt = nt; return true; }
};
struct SchedBO {
    static constexpr bool UNIFORM_LD = false;
    TileOrder o; const char* XB; const char* PM; const char* WgT; const char* WboT;
    DI bool get(int i, UnitD& u) const { const int ti = i / 6, sub = i - ti * 6, br = sub >> 1; int pm, pn; if (!o.tile(ti, pm, pn)) return false; u.pm = pm; u.pn = pn; u.aux = sub;
        if ((sub & 1) == 0) { u.A = XB + (size_t)pm * BM * 2048; u.lda2 = 2048; u.B = WgT + (size_t)(br * 1024 + pn * BM) * 2048; u.ldb2 = 2048; u.nt = 16; }
        else { const int yc = br == 0 ? 0 : (br == 1 ? 1536 : 2560); u.A = PM + (size_t)pm * BM * (PMP * 2) + yc * 2; u.lda2 = PMP * 2; u.B = WboT + (size_t)(br * 1024 + pn * BM) * 1024; u.ldb2 = 1024; u.nt = 8; }
        return true; }
};

DI void row_rs8(const float* part, int row0, int fq, float (&rs)[2][4]) {
    f32x4 v[2][4];
#pragma unroll
    for (int ai = 0; ai < 2; ++ai)
#pragma unroll
        for (int m = 0; m < 4; ++m) v[ai][m] = *((const f32x4*)(part + (size_t)(row0 + ai * HALF + m * 16) * 16) + fq);
#pragma unroll
    for (int ai = 0; ai < 2; ++ai)
#pragma unroll
        for (int m = 0; m < 4; ++m) { float s_ = (v[ai][m][0] + v[ai][m][1]) + (v[ai][m][2] + v[ai][m][3]); s_ += __shfl_xor(s_, 16); s_ += __shfl_xor(s_, 32); rs[ai][m] = 1.0f / sqrtf(s_ * (1.0f / 1024.0f) + EPS); }
}
template <class Epi, class Sched>
DI void gemm_phase(LAS unsigned char* lds, const Sched& S, const Epi& E) {
    int tid_ = threadIdx.x; asm volatile("" : "+v"(tid_)); const int tid = tid_, wid = __builtin_amdgcn_readfirstlane(tid >> 6), lane = tid & 63, wr = wid >> 2, wc = wid & 3, fr = lane & 15, fq = lane >> 4;
#define PG8_VOFFS(lda_, ldb_, oA0, oA1, oB0, oB1) do { int t2_ = tid; asm volatile("" : "+v"(t2_)); int R0_, C0_, R1_, C1_; stage_rc(t2_ * 16, R0_, C0_); stage_rc(t2_ * 16 + 8192, R1_, C1_); \
        const int Rb0_ = (R0_ & ~31) + perm32(R0_ & 31), Rb1_ = (R1_ & ~31) + perm32(R1_ & 31); \
        oA0 = (unsigned)R0_ * (lda_) + C0_ * 2; oA1 = (unsigned)R1_ * (lda_) + C1_ * 2; oB0 = (unsigned)Rb0_ * (ldb_) + C0_ * 2; oB1 = (unsigned)Rb1_ * (ldb_) + C1_ * 2; } while (0)
    const size_t kstep = (size_t)(BK * 2);
    const unsigned ldsw = (unsigned)wid * 1024u;
    const int aoff = lds_byte(wr * 64 + fr, fq * 8), boff = lds_byte(wc * 32 + fr, fq * 8);
#define PG8_SA(b, h) (((b) * 2 + (h)) * HTB)
#define PG8_SB(b, h) ((4 + (b) * 2 + (h)) * HTB)
#define PG8_STAGE(bufoff, gbase, v0, v1) do { \
        __builtin_amdgcn_global_load_lds((const unsigned*)((const char*)(gbase) + (v0)), (LAS unsigned*)(lds + (bufoff) + ldsw), 16, 0, 0); \
        __builtin_amdgcn_global_load_lds((const unsigned*)((const char*)(gbase) + (v1)), (LAS unsigned*)(lds + (bufoff) + ldsw + 8192), 16, 0, 0); } while (0)
#define PG8_LDA(dst, b, h) do { _Pragma("unroll") for (int m = 0; m < 4; ++m) _Pragma("unroll") for (int k = 0; k < 2; ++k) dst[m][k] = *(const LAS bf16x8*)(lds + PG8_SA(b, h) + aoff + m * 2048 + k * 1024); } while (0)
#define PG8_LDB(dst, b, h) do { _Pragma("unroll") for (int n = 0; n < 2; ++n) _Pragma("unroll") for (int k = 0; k < 2; ++k) dst[n][k] = *(const LAS bf16x8*)(lds + PG8_SB(b, h) + boff + n * 2048 + k * 1024); } while (0)
#define PG8_MMA(ai, bj, At, Bt) do { __builtin_amdgcn_s_setprio(1); _Pragma("unroll") for (int m = 0; m < 4; ++m) _Pragma("unroll") for (int n = 0; n < 2; ++n) _Pragma("unroll") for (int k = 0; k < 2; ++k) \
        acc[ai][bj][m][n] = __builtin_amdgcn_mfma_f32_16x16x32_bf16(Bt[n][k], At[m][k], acc[ai][bj][m][n], 0, 0, 0); __builtin_amdgcn_s_setprio(0); } while (0)
#define PG8_WAIT_V(n) asm volatile("s_waitcnt vmcnt(" #n ")" ::: "memory")
#define PG8_WAIT_L(n) asm volatile("s_waitcnt lgkmcnt(" #n ")" ::: "memory")
#define PG8_BAR __builtin_amdgcn_s_barrier()
#define PG8_SCHED __builtin_amdgcn_sched_barrier(0)
    UnitD cur, nxt; int ui = 0;
    if (!S.get(0, cur)) return;
    float rsc[2][4]; int rs_pm = cur.pm;
    if constexpr (Epi::NEEDS_RS) row_rs8(E.part, cur.pm * BM + wr * 64 + fr, fq, rsc);
    f32x4 acc[2][2][4][2];
#pragma unroll
    for (int a = 0; a < 2; ++a)
#pragma unroll
        for (int b = 0; b < 2; ++b)
#pragma unroll
            for (int m = 0; m < 4; ++m)
#pragma unroll
                for (int n = 0; n < 2; ++n) acc[a][b][m][n] = (f32x4){0.f, 0.f, 0.f, 0.f};
    bf16x8 At[4][2], B0[2][2], B1[2][2];
    const char* cA = cur.A; const char* cB = cur.B;
    unsigned vA0, vA1, vB0, vB1; PG8_VOFFS(cur.lda2, cur.ldb2, vA0, vA1, vB0, vB1);
    size_t hA = (size_t)HALF * cur.lda2, hB = (size_t)HALF * cur.ldb2;
    PG8_STAGE(PG8_SB(0, 0), cB, vB0, vB1); PG8_STAGE(PG8_SB(0, 1), cB + hB, vB0, vB1); PG8_STAGE(PG8_SA(0, 0), cA, vA0, vA1); PG8_STAGE(PG8_SA(0, 1), cA + hA, vA0, vA1);
    if (wr == 1) PG8_BAR;
    PG8_WAIT_V(2); PG8_BAR;
    PG8_STAGE(PG8_SB(1, 0), cB + kstep, vB0, vB1); PG8_STAGE(PG8_SA(1, 0), cA + kstep, vA0, vA1); PG8_STAGE(PG8_SB(1, 1), cB + hB + kstep, vB0, vB1);
    PG8_WAIT_V(6); PG8_BAR;
    for (;;) {
        const bool has_next = S.get(ui + 1, nxt);
        const char* nA = has_next ? nxt.A : cA; const char* nB = has_next ? nxt.B : cB;
        unsigned nvA0 = vA0, nvA1 = vA1, nvB0 = vB0, nvB1 = vB1; size_t nhA = hA, nhB = hB;
        if constexpr (!Sched::UNIFORM_LD) {
            const unsigned nlda = has_next ? nxt.lda2 : cur.lda2, nldb = has_next ? nxt.ldb2 : cur.ldb2;
            PG8_VOFFS(nlda, nldb, nvA0, nvA1, nvB0, nvB1); nhA = (size_t)HALF * nlda; nhB = (size_t)HALF * nldb;
        }
        const int nt = cur.nt;
        for (int t = 0; t < nt; t += 2) {
            const bool last = (t == nt - 2);
            const char* a1 = cA + (size_t)(t + 1) * kstep;
            const char* a2 = last ? nA : cA + (size_t)(t + 2) * kstep; const char* b2 = last ? nB : cB + (size_t)(t + 2) * kstep;
            const char* a3 = a2 + kstep; const char* b3 = b2 + kstep;
            const unsigned xA0 = last ? nvA0 : vA0, xA1 = last ? nvA1 : vA1, xB0 = last ? nvB0 : vB0, xB1 = last ? nvB1 : vB1;
            const size_t xhA = last ? nhA : hA, xhB = last ? nhB : hB;
            PG8_LDB(B0, 0, 0); PG8_LDB(B1, 0, 1); PG8_SCHED; PG8_LDA(At, 0, 0); PG8_STAGE(PG8_SA(1, 1), a1 + hA, vA0, vA1);
            PG8_WAIT_V(8); PG8_WAIT_L(0); PG8_BAR; PG8_MMA(0, 0, At, B0); PG8_MMA(0, 1, At, B1); PG8_BAR; PG8_SCHED;
            PG8_LDA(At, 0, 1); PG8_STAGE(PG8_SB(0, 0), b2, xB0, xB1); PG8_STAGE(PG8_SB(0, 1), b2 + xhB, xB0, xB1); PG8_STAGE(PG8_SA(0, 0), a2, xA0, xA1);
            PG8_WAIT_V(8); PG8_WAIT_L(0); PG8_BAR; PG8_MMA(1, 0, At, B0); PG8_MMA(1, 1, At, B1); PG8_BAR; PG8_SCHED;
            PG8_LDB(B0, 1, 0); PG8_LDB(B1, 1, 1); PG8_SCHED; PG8_LDA(At, 1, 0); PG8_STAGE(PG8_SA(0, 1), a2 + xhA, xA0, xA1);
            PG8_WAIT_V(8); PG8_WAIT_L(0); PG8_BAR; PG8_MMA(0, 0, At, B0); PG8_MMA(0, 1, At, B1); PG8_BAR; PG8_SCHED;
            PG8_LDA(At, 1, 1); PG8_STAGE(PG8_SB(1, 0), b3, xB0, xB1); PG8_STAGE(PG8_SB(1, 1), b3 + xhB, xB0, xB1); PG8_STAGE(PG8_SA(1, 0), a3, xA0, xA1);
            PG8_WAIT_V(8); PG8_WAIT_L(0); PG8_BAR; PG8_MMA(1, 0, At, B0); PG8_MMA(1, 1, At, B1); PG8_BAR; PG8_SCHED;
        }
        if (wr == 0) PG8_BAR;
        if constexpr (Epi::NEEDS_RS) { if (cur.pm != rs_pm) { row_rs8(E.part, cur.pm * BM + wr * 64 + fr, fq, rsc); rs_pm = cur.pm; } E(acc, cur, wr, wc, fr, fq, rsc); }
        else E(acc, cur, wr, wc, fr, fq);
        if (!has_next) break;
#pragma unroll
        for (int a = 0; a < 2; ++a)
#pragma unroll
            for (int b = 0; b < 2; ++b)
#pragma unroll
                for (int m = 0; m < 4; ++m)
#pragma unroll
                    for (int n = 0; n < 2; ++n) acc[a][b][m][n] = (f32x4){0.f, 0.f, 0.f, 0.f};
        cur = nxt; cA = nA; cB = nB; ++ui; vA0 = nvA0; vA1 = nvA1; vB0 = nvB0; vB1 = nvB1; hA = nhA; hB = nhB;
        if (wr == 1) PG8_BAR;
    }
    PG8_WAIT_V(0);
    PG8_BAR;
#undef PG8_VOFFS
#undef PG8_SA
#undef PG8_SB
#undef PG8_STAGE
#undef PG8_LDA
#undef PG8_LDB
#undef PG8_MMA
#undef PG8_WAIT_V
#undef PG8_WAIT_L
#undef PG8_BAR
#undef PG8_SCHED
}

DI u32x4 pk8(const f32x4 v0, const f32x4 v1) { u32x4 w; w.x = cvt_pk_bf16(v0[0], v0[1]); w.y = cvt_pk_bf16(v0[2], v0[3]); w.z = cvt_pk_bf16(v1[0], v1[1]); w.w = cvt_pk_bf16(v1[2], v1[3]); return w; }

struct EpiMain {
    static constexpr bool NEEDS_RS = true;
    bf16_t* PM; const float* part; float* rsv;
    DI void operator()(const f32x4 (&acc)[2][2][4][2], const UnitD& u, int wr, int wc, int fr, int fq, const float (&rs)[2][4]) const {
        const int row0 = u.pm * BM + wr * 64 + fr, col0 = u.pn * BM + wc * 32 + 8 * fq; const bool gl = (u.pn >= 6 && u.pn < 10);
#pragma unroll
        for (int ai = 0; ai < 2; ++ai)
#pragma unroll
            for (int m = 0; m < 4; ++m) { const int row = row0 + ai * HALF + m * 16; const float r_ = rs[ai][m]; bf16_t* rowp = PM + (size_t)row * PMP + col0;
                if (u.pn == 0 && wc == 0 && fq == 0) rsv[row] = r_;
                if (u.pn >= 2 && u.pn < 6) {
                    float o[8];
#pragma unroll
                    for (int n = 0; n < 2; ++n) { const f32x4 cg = acc[ai][0][m][n] * r_, xa = acc[ai][1][m][n] * r_;
#pragma unroll
                        for (int e = 0; e < 4; ++e) o[4 * n + e] = cg[e] * xa[e]; }
                    *(u32x4*)(PM + (size_t)row * PMP + 512 + 128 * (u.pn - 2) + wc * 32 + 8 * fq) = pack8(o);
                } else {
#pragma unroll
                for (int bj = 0; bj < 2; ++bj) { f32x4 v0 = acc[ai][bj][m][0] * r_, v1 = acc[ai][bj][m][1] * r_; if (gl) { v0 = gelu4(v0); v1 = gelu4(v1); }
                    *(u32x4*)(rowp + bj * HALF) = pk8(v0, v1); } } }
    }
};
struct EpiBO {
    static constexpr bool NEEDS_RS = false;
    bf16_t* PM; const float* rsv; const float* bgate;
    DI void operator()(const f32x4 (&acc)[2][2][4][2], const UnitD& u, int wr, int wc, int fr, int fq) const {
        const int row0 = u.pm * BM + wr * 64 + fr, col0 = u.pn * BM + wc * 32 + 8 * fq, br = u.aux >> 1;
        if ((u.aux & 1) == 0) {
            f32x4 bv[2][2]; float rs[2][4];
#pragma unroll
            for (int bj = 0; bj < 2; ++bj)
#pragma unroll
                for (int n = 0; n < 2; ++n) bv[bj][n] = *(const f32x4*)(bgate + br * 1024 + col0 + bj * HALF + 4 * n);
#pragma unroll
            for (int ai = 0; ai < 2; ++ai)
#pragma unroll
                for (int m = 0; m < 4; ++m) rs[ai][m] = rsv[row0 + ai * HALF + m * 16];
#pragma unroll
            for (int ai = 0; ai < 2; ++ai)
#pragma unroll
                for (int m = 0; m < 4; ++m) { const int row = row0 + ai * HALF + m * 16; const float r_ = rs[ai][m];
#pragma unroll
                    for (int bj = 0; bj < 2; ++bj) { f32x4 v0 = acc[ai][bj][m][0] * r_ + bv[bj][0], v1 = acc[ai][bj][m][1] * r_ + bv[bj][1];
                        unsigned q0 = 0u, q1 = 0u;
#pragma unroll
                        for (int e = 0; e < 4; ++e) { q0 |= (unsigned)(sigmoidf_(v0[e]) * 255.0f + 0.5f) << (8 * e); q1 |= (unsigned)(sigmoidf_(v1[e]) * 255.0f + 0.5f) << (8 * e); }
                        *(u32x2*)((unsigned char*)(PM + (size_t)row * PMP + COL_GS) + col0 + bj * HALF) = (u32x2){q0, q1}; } }
        } else {
#pragma unroll
            for (int ai = 0; ai < 2; ++ai) {
                u32x2 gw[4][2]; u32x4 mw[4][2];
#pragma unroll
                for (int m = 0; m < 4; ++m)
#pragma unroll
                    for (int bj = 0; bj < 2; ++bj) { const size_t rr_ = (size_t)(row0 + ai * HALF + m * 16) * PMP, ro = rr_ + col0 + bj * HALF; gw[m][bj] = *(const u32x2*)((const unsigned char*)(PM + rr_ + COL_GS) + col0 + bj * HALF); mw[m][bj] = (br > 0) ? *(const u32x4*)(PM + ro + COL_MG) : (u32x4){0u, 0u, 0u, 0u}; }
#pragma unroll
                for (int m = 0; m < 4; ++m)
#pragma unroll
                    for (int bj = 0; bj < 2; ++bj) { float g[8], o[8], pv_[8]; unpack8(mw[m][bj], pv_);
#pragma unroll
                        for (int e = 0; e < 4; ++e) { g[e] = (float)((gw[m][bj].x >> (8 * e)) & 0xffu) * (1.0f / 255.0f); g[4 + e] = (float)((gw[m][bj].y >> (8 * e)) & 0xffu) * (1.0f / 255.0f); }
                        const f32x4 a0 = acc[ai][bj][m][0], a1 = acc[ai][bj][m][1];
#pragma unroll
                        for (int e = 0; e < 4; ++e) { o[e] = a0[e] * g[e] + pv_[e]; o[4 + e] = a1[e] * g[4 + e] + pv_[4 + e]; }
                        *(u32x4*)(PM + (size_t)(row0 + ai * HALF + m * 16) * PMP + col0 + bj * HALF + COL_MG) = pack8(o); }
                asm volatile("" ::: "memory");
            }
        }
    }
};
struct EpiRes {
    static constexpr bool NEEDS_RS = false;
    float* out; bf16_t* XB; float* part;
    DI void operator()(const f32x4 (&acc)[2][2][4][2], const UnitD& u, int wr, int wc, int fr, int fq) const {
        const int row0 = u.pm * BM + wr * 64 + fr, col0 = u.pn * BM + wc * 32 + 8 * fq;
        u32x4 xw[2][4][2];
#pragma unroll
        for (int ai = 0; ai < 2; ++ai)
#pragma unroll
            for (int m = 0; m < 4; ++m)
#pragma unroll
                for (int bj = 0; bj < 2; ++bj) xw[ai][m][bj] = *(const u32x4*)(XB + (size_t)(row0 + ai * HALF + m * 16) * D_ + col0 + bj * HALF);
#pragma unroll
        for (int ai = 0; ai < 2; ++ai)
#pragma unroll
            for (int m = 0; m < 4; ++m) { const int row = row0 + ai * HALF + m * 16; const size_t off = (size_t)row * D_ + col0; float ss = 0.f;
#pragma unroll
                for (int bj = 0; bj < 2; ++bj) { float b[8]; unpack8(xw[ai][m][bj], b);
                    const f32x4 a0 = acc[ai][bj][m][0], a1 = acc[ai][bj][m][1];
                    const f32x4 x0 = (f32x4){b[0] + a0[0], b[1] + a0[1], b[2] + a0[2], b[3] + a0[3]}, x1 = (f32x4){b[4] + a1[0], b[5] + a1[1], b[6] + a1[2], b[7] + a1[3]};
                    if (out) { *(f32x4*)(out + off + bj * HALF) = x0; *(f32x4*)(out + off + bj * HALF + 4) = x1; }
                    else { *(u32x4*)(XB + off + bj * HALF) = pk8(x0, x1);
                        ss += ((x0[0] * x0[0] + x0[1] * x0[1]) + (x0[2] * x0[2] + x0[3] * x0[3])) + ((x1[0] * x1[0] + x1[1] * x1[1]) + (x1[2] * x1[2] + x1[3] * x1[3])); } }
                if (!out) { ss += __shfl_xor(ss, 16); ss += __shfl_xor(ss, 32);
                    if (fq == 0) part[(size_t)row * 16 + u.pn * 4 + wc] = ss; } }
    }
};
struct EpiGU {
    static constexpr bool NEEDS_RS = true;
    bf16_t* ACT; const float* part;
    DI void operator()(const f32x4 (&acc)[2][2][4][2], const UnitD& u, int wr, int wc, int fr, int fq, const float (&rs)[2][4]) const {
        const int row0 = u.pm * BM + wr * 64 + fr, col0 = u.pn * HALF + wc * 32 + 8 * fq;
#pragma unroll
        for (int ai = 0; ai < 2; ++ai)
#pragma unroll
            for (int m = 0; m < 4; ++m) { const int row = row0 + ai * HALF + m * 16; const float r_ = rs[ai][m]; float o[8];
#pragma unroll
                for (int n = 0; n < 2; ++n) { const f32x4 g = acc[ai][0][m][n] * r_, uu = acc[ai][1][m][n] * r_;
#pragma unroll
                    for (int e = 0; e < 4; ++e) o[4 * n + e] = g[e] * sigmoidf_(g[e]) * uu[e]; }
                *(u32x4*)(ACT + (size_t)(row >> 8) * ((size_t)PMP * 256) + (size_t)(row & 255) * DFF + col0) = pack8(o); }
    }
};
}

DI void transpose_item(const float* W, int N, int Kd, const float* kscale, bf16_t* WT, int k0, int n0, int drow0, LAS float* scr, int lane) {
    const int kq = lane >> 4, nq = (lane & 15) * 4;
    f32x4 v[16];
#pragma unroll
    for (int i = 0; i < 16; ++i) v[i] = __builtin_nontemporal_load((const f32x4*)(W + (size_t)(k0 + 4 * i + kq) * N + n0 + nq));
#pragma unroll
    for (int i = 0; i < 16; ++i) { const int kk = 4 * i + kq; const float sc = kscale ? kscale[k0 + kk] : 1.0f; LAS float* d = scr + kk * 65 + nq;
        d[0] = v[i][0] * sc; d[1] = v[i][1] * sc; d[2] = v[i][2] * sc; d[3] = v[i][3] * sc; }
    asm volatile("s_waitcnt lgkmcnt(0)" ::: "memory");
    const int c = lane & 7;
#pragma unroll
    for (int j = 0; j < 8; ++j) { const int n = (lane >> 3) + 8 * j; const LAS float* s_ = scr + (8 * c) * 65 + n;
        u32x4 o; o.x = cvt_pk_bf16(s_[0 * 65], s_[1 * 65]); o.y = cvt_pk_bf16(s_[2 * 65], s_[3 * 65]); o.z = cvt_pk_bf16(s_[4 * 65], s_[5 * 65]); o.w = cvt_pk_bf16(s_[6 * 65], s_[7 * 65]);
        *(u32x4*)(WT + (size_t)(drow0 + n) * Kd + k0 + 8 * c) = o; }
    asm volatile("s_waitcnt lgkmcnt(0)" ::: "memory");
}

struct Params {
    const float* x; const float* mix_g; const float* w_in; const float* b_gate; const float* conv_w; const float* conv_b;
    const float* ln_g; const float* ln_b; const float* sgu_w; const float* sgu_b; const float* qg; const float* kg;
    const float* w_bo; const float* w_o; const float* ffn_g; const float* w_gu; const float* w_dn;
    float* out; unsigned char* ws; int ph_lo, ph_hi;
};

constexpr int I_MAIN = 16 * 64, I_IN = 16 * 112, I_BO = 3 * 8 * 16, I_O = 16 * 16, I_GU = 16 * 88, I_DN = 44 * 16, I_REST = I_BO + I_O + I_GU + I_DN;
DI int win_row(int nb) { if (nb >= 8 && nb < 16) { const int cc = 64 * nb - 512; return 512 + 256 * (cc / 128) + (cc % 128); } if (nb >= 16 && nb < 24) { const int cc = 64 * nb - 1024; return 512 + 256 * (cc / 128) + 128 + (cc % 128); } return 64 * nb; }
DI void convert_items(const Params& p, LAS unsigned char* lds, int first, int count) {
    int tid_ = threadIdx.x; asm volatile("" : "+v"(tid_)); const int tid = tid_, lane = tid & 63, wave = tid >> 6;
    LAS float* scr = (LAS float*)(lds + wave * 16640);
    const int gw = blockIdx.x * 8 + wave, NGW = gridDim.x * 8;
    for (int it = first + gw; it < first + count; it += NGW) {
        if (it < 2 * I_IN) { int l, kb, nb;
            if (it < I_MAIN) { l = 0; kb = it / 64; nb = it % 64; }
            else if (it < I_IN) { const int r = it - I_MAIN; l = 0; kb = r / 48; nb = 64 + r % 48; }
            else { const int r = it - I_IN; l = 1; kb = r / 112; nb = r % 112; }
            unsigned char* wl = p.ws + (size_t)l * WS_WL;
            transpose_item(p.w_in + (size_t)l * D_ * NIN, NIN, 1024, p.mix_g + l * D_, (bf16_t*)(wl + W_IN), 64 * kb, 64 * nb, win_row(nb), scr, lane); continue; }
        const int q = it - 2 * I_IN, l = q / I_REST; int r = q - l * I_REST; unsigned char* wl = p.ws + (size_t)l * WS_WL;
        if (r < I_BO) { const int i = r / 128, rr = r % 128, kb = rr / 16, nb = rr % 16; transpose_item(p.w_bo + ((size_t)l * 3 + i) * 512 * 1024, 1024, 512, nullptr, (bf16_t*)(wl + W_BO) + (size_t)i * 1024 * 512, 64 * kb, 64 * nb, 64 * nb, scr, lane); continue; } r -= I_BO;
        if (r < I_O) { const int kb = r / 16, nb = r % 16; transpose_item(p.w_o + (size_t)l * 1024 * 1024, 1024, 1024, nullptr, (bf16_t*)(wl + W_O), 64 * kb, 64 * nb, 64 * nb, scr, lane); continue; } r -= I_O;
        if (r < I_GU) { const int kb = r / 88, nb = r % 88, n0 = 64 * nb, cc = n0 < DFF ? n0 : n0 - DFF, dr = 256 * (cc / 128) + (cc % 128) + (n0 < DFF ? 0 : 128);
            transpose_item(p.w_gu + (size_t)l * 1024 * NGU, NGU, 1024, p.ffn_g + l * D_, (bf16_t*)(wl + W_GU), 64 * kb, n0, dr, scr, lane); continue; } r -= I_GU;
        { const int kb = r / 16, nb = r % 16; transpose_item(p.w_dn + (size_t)l * DFF * 1024, 1024, DFF, nullptr, (bf16_t*)(wl + W_DN), 64 * kb, 64 * nb, 64 * nb, scr, lane); }
    }
}
DI void phase0(const Params& p, LAS unsigned char* lds, int mode, int row_base) {
    int tid_ = threadIdx.x; asm volatile("" : "+v"(tid_)); const int tid = tid_, lane = tid & 63, wave = tid >> 6;
    const int gw = blockIdx.x * 8 + wave, NGW = gridDim.x * 8;
    if (mode != 2) {
    convert_items(p, lds, 0, I_MAIN);
    for (int i = blockIdx.x * 512 + tid; i < 2 * 4 * 128 * 128; i += gridDim.x * 512) {
        const int l = i >> 16, rem = i & 65535, t = (rem >> 7) & 127, s = rem & 127; const float w = p.sgu_w[i];
        ((bf16_t*)(p.ws + (size_t)l * WS_WL + W_SG))[rem] = f2bf(s <= t ? w : 0.f);
    }
    }
    if (mode == 0) return;
    bf16_t* XB = (bf16_t*)(p.ws + WS_XB); float* part = (float*)(p.ws + WS_PART);
    const int mfirst = (mode == 2) ? row_base + wave * 8 : gw, mstep = (mode == 2) ? 1 : NGW, mend = (mode == 2) ? row_base + wave * 8 + 8 : T_;
    for (int m0 = mfirst; m0 < mend; m0 += 4 * mstep) {
        f32x4 v[4][4];
#pragma unroll
        for (int q = 0; q < 4; ++q) { const int m = m0 + q * mstep; const f32x4* xr = (const f32x4*)(p.x + (size_t)(m < mend ? m : m0) * D_) + lane;
#pragma unroll
            for (int j = 0; j < 4; ++j) v[q][j] = __builtin_nontemporal_load(xr + 64 * j); }
#pragma unroll
        for (int q = 0; q < 4; ++q) { const int m = m0 + q * mstep; if (m < mend) { float ss = 0.f; u32x2* o8 = (u32x2*)(XB + (size_t)m * D_) + lane;
#pragma unroll
            for (int j = 0; j < 4; ++j) { const f32x4 w_ = v[q][j]; ss += (w_[0] * w_[0] + w_[1] * w_[1]) + (w_[2] * w_[2] + w_[3] * w_[3]); u32x2 w; w.x = cvt_pk_bf16(w_[0], w_[1]); w.y = cvt_pk_bf16(w_[2], w_[3]); o8[64 * j] = w; }
            ss = wave_sum(ss);
            if (lane < 16) part[(size_t)m * 16 + lane] = lane == 0 ? ss : 0.f; } }
    }
}

DI int crow(int r, int hi) { return (r & 3) + 8 * (r >> 2) + 4 * hi; }

constexpr int AT_K = 0, AT_V = 8192, AT_BUF = 16384, AT_FLAG = 32768, AT_OST = 32768 + 256;
DI void pv_acc(f32x16& o0, f32x16& o1, int vb, bf16x8 pa0, bf16x8 pa1, bf16x8 pa2, bf16x8 pa3) {
#pragma unroll
    for (int d0 = 0; d0 < 2; ++d0) { s16x4 lo[4], hi[4];
#pragma unroll
        for (int ks = 0; ks < 4; ++ks) {
            asm volatile("ds_read_b64_tr_b16 %0,%1 offset:%c2" : "=&v"(lo[ks]) : "v"(vb), "i"(d0 * 4096 + ks * 1024) : "memory");
            asm volatile("ds_read_b64_tr_b16 %0,%1 offset:%c2" : "=&v"(hi[ks]) : "v"(vb), "i"(d0 * 4096 + ks * 1024 + 512) : "memory"); }
        asm volatile("s_waitcnt lgkmcnt(0)" ::: "memory"); __builtin_amdgcn_sched_barrier(0);
#define PK(k) (bf16x8){lo[k][0], lo[k][1], lo[k][2], lo[k][3], hi[k][0], hi[k][1], hi[k][2], hi[k][3]}
        f32x16 o = d0 ? o1 : o0;
        o = __builtin_amdgcn_mfma_f32_32x32x16_bf16(pa0, PK(0), o, 0, 0, 0);
        o = __builtin_amdgcn_mfma_f32_32x32x16_bf16(pa1, PK(1), o, 0, 0, 0);
        o = __builtin_amdgcn_mfma_f32_32x32x16_bf16(pa2, PK(2), o, 0, 0, 0);
        o = __builtin_amdgcn_mfma_f32_32x32x16_bf16(pa3, PK(3), o, 0, 0, 0);
        if (d0) o1 = o; else o0 = o;
#undef PK
    }
}

DI void attn_unit(LAS unsigned char* lds, bf16_t* PM, const float* gq, const float* gk, int b, int h, int qb, bf16_t* dmy) {
    int tid_ = threadIdx.x; asm volatile("" : "+v"(tid_)); const int tid = tid_, lane = tid & 63, r32 = lane & 31, hi = lane >> 5, wid = __builtin_amdgcn_readfirstlane(tid >> 6);
    const int q0 = qb * 256; const size_t rowbase = (size_t)b * SEQ_;
    bf16x8 qr[4];
    {
        const bf16_t* Qp = PM + (rowbase + q0 + wid * 32 + r32) * PMP + 2560 + h * 64 + hi * 8;
        float qf[4][8]; float ss = 0.f;
#pragma unroll
        for (int d0 = 0; d0 < 4; ++d0) { unpack8(*(const u32x4*)(Qp + d0 * 16), qf[d0]);
#pragma unroll
            for (int e = 0; e < 8; ++e) ss += qf[d0][e] * qf[d0][e]; }
        ss += __shfl_xor(ss, 32);
        const float sc = C2 / sqrtf(ss * (1.0f / 64.0f) + EPS);
#pragma unroll
        for (int d0 = 0; d0 < 4; ++d0) { float t[8];
#pragma unroll
            for (int e = 0; e < 8; ++e) t[e] = qf[d0][e] * sc * gq[d0 * 16 + hi * 8 + e];
            qr[d0] = __builtin_bit_cast(bf16x8, pack8(t)); }
    }
    const int key = tid >> 3, ch = tid & 7;
    float gkv[8];
#pragma unroll
    for (int e = 0; e < 8; ++e) gkv[e] = gk[ch * 8 + e];
    const bf16_t* kvp = PM + (rowbase + key) * PMP + 3072 + h * 64 + ch * 8;
    LAS unsigned char* kdst = lds + AT_K + ch * 1024 + key * 16;
    LAS unsigned char* vdst = lds + AT_V + ((ch >> 2) * 4 + (key >> 4)) * 1024 + (key & 15) * 64 + (ch & 3) * 16;
    const LAS unsigned char* kb = lds + AT_K + hi * 1024 + r32 * 16;
    const int vb0 = (int)(unsigned)(uintptr_t)(lds + AT_V) + ((lane >> 4) & 1) * 32 + (lane & 3) * 8 + (4 * hi + ((lane & 15) >> 2)) * 64;
    volatile LAS unsigned* flags = (volatile LAS unsigned*)(lds + AT_FLAG);
    const int NT = (q0 + 256) / 64, wq0 = q0 + wid * 32, qi = wq0 + r32;
    float carry = 0.f; f32x16 o0, o1;
#pragma unroll
    for (int r = 0; r < 16; ++r) { o0[r] = 0.f; o1[r] = 0.f; }
    bool wdone = false;
#define AT_STAGE(kr, vr, bsel) do { float kf[8]; unpack8(kr, kf); float ss_ = 0.f; \
        _Pragma("unroll") for (int e = 0; e < 8; ++e) ss_ += kf[e] * kf[e]; \
        ss_ += __shfl_xor(ss_, 1); ss_ += __shfl_xor(ss_, 2); ss_ += __shfl_xor(ss_, 4); \
        const float sc_ = 1.0f / sqrtf(ss_ * (1.0f / 64.0f) + EPS); \
        _Pragma("unroll") for (int e = 0; e < 8; ++e) kf[e] = kf[e] * sc_ * gkv[e]; \
        *(LAS u32x4*)(kdst + (bsel) * AT_BUF) = pack8(kf); *(LAS u32x4*)(vdst + (bsel) * AT_BUF) = vr; } while (0)
    u32x4 kraw = __builtin_nontemporal_load((const u32x4*)(kvp + (size_t)(NT - 1) * 64 * PMP)), vraw = __builtin_nontemporal_load((const u32x4*)(kvp + (size_t)(NT - 1) * 64 * PMP + 512));
    __syncthreads();
    AT_STAGE(kraw, vraw, (NT - 1) & 1);
    if (NT > 1) { kraw = __builtin_nontemporal_load((const u32x4*)(kvp + (size_t)(NT - 2) * 64 * PMP)); vraw = __builtin_nontemporal_load((const u32x4*)(kvp + (size_t)(NT - 2) * 64 * PMP + 512)); }
    for (int jt = NT - 1; jt >= 0; --jt) {
        __syncthreads();
        if (jt < NT - 1) { unsigned all = 1u;
#pragma unroll
            for (int w = 0; w < 8; ++w) all &= flags[((jt + 1) & 1) * 8 + w];
            if (all) break; }
        if (jt > 0) { AT_STAGE(kraw, vraw, (jt - 1) & 1);
            if (jt > 1) { kraw = __builtin_nontemporal_load((const u32x4*)(kvp + (size_t)(jt - 2) * 64 * PMP)); vraw = __builtin_nontemporal_load((const u32x4*)(kvp + (size_t)(jt - 2) * 64 * PMP + 512)); } }
        const int bo_ = (jt & 1) * AT_BUF;
        const int k0 = jt * 64;
        if (!wdone && k0 <= wq0) {
            f32x16 p0, p1;
#pragma unroll
            for (int r = 0; r < 16; ++r) { p0[r] = 0.f; p1[r] = 0.f; }
#pragma unroll
            for (int d0 = 0; d0 < 4; ++d0) { const bf16x8 b0 = *(const LAS bf16x8*)(kb + bo_ + d0 * 2048), b1 = *(const LAS bf16x8*)(kb + bo_ + d0 * 2048 + 512);
                p0 = __builtin_amdgcn_mfma_f32_32x32x16_bf16(b0, qr[d0], p0, 0, 0, 0); p1 = __builtin_amdgcn_mfma_f32_32x32x16_bf16(b1, qr[d0], p1, 0, 0, 0); }
            const bool needmask = (k0 + 63 >= wq0);
            float Lr[32], lb[32];
            if (needmask) {
#pragma unroll
                for (int i = 0; i < 32; ++i) { const float z = i < 16 ? p0[i] : p1[i - 16]; const int r = i & 15;
                    const float e = __builtin_amdgcn_exp2f(-fabsf(z)); const float sp = fmaxf(z, 0.f) + __builtin_amdgcn_logf(1.0f + e);
                    const bool valid = (k0 + (i >> 4) * 32 + crow(r, hi) < qi);
                    Lr[i] = valid ? -sp : 0.f; lb[i] = valid ? z - sp : -INFINITY; }
            } else {
#pragma unroll
                for (int i = 0; i < 32; ++i) { const float z = i < 16 ? p0[i] : p1[i - 16];
                    const float e = __builtin_amdgcn_exp2f(-fabsf(z)); const float sp = fmaxf(z, 0.f) + __builtin_amdgcn_logf(1.0f + e);
                    Lr[i] = -sp; lb[i] = z - sp; }
            }
            float Tj[8], ex[8];
#pragma unroll
            for (int j = 0; j < 8; ++j) { const float g = (Lr[4 * j] + Lr[4 * j + 1]) + (Lr[4 * j + 2] + Lr[4 * j + 3]);
                auto rr = __builtin_amdgcn_permlane32_swap(__float_as_uint(g), __float_as_uint(g), false, false);
                const float lo = __uint_as_float(rr[0]), hv = __uint_as_float(rr[1]); Tj[j] = lo + hv; ex[j] = hi ? 0.f : hv; }
            float suf = carry; float w[32];
#pragma unroll
            for (int j = 7; j >= 0; --j) { const float a3 = suf + ex[j], a2 = a3 + Lr[4 * j + 3], a1 = a2 + Lr[4 * j + 2], a0 = a1 + Lr[4 * j + 1];
                w[4 * j + 3] = __builtin_amdgcn_exp2f(lb[4 * j + 3] + a3); w[4 * j + 2] = __builtin_amdgcn_exp2f(lb[4 * j + 2] + a2);
                w[4 * j + 1] = __builtin_amdgcn_exp2f(lb[4 * j + 1] + a1); w[4 * j] = __builtin_amdgcn_exp2f(lb[4 * j] + a0);
                suf += Tj[j]; }
            carry = suf;
            wdone = __all(carry < THR2) != 0;
            const bf16x8 pa0 = __builtin_bit_cast(bf16x8, pack8(w)), pa1 = __builtin_bit_cast(bf16x8, pack8(w + 8)), pa2 = __builtin_bit_cast(bf16x8, pack8(w + 16)), pa3 = __builtin_bit_cast(bf16x8, pack8(w + 24));
            pv_acc(o0, o1, vb0 + bo_, pa0, pa1, pa2, pa3);
        }
        if (lane == 0) flags[(jt & 1) * 8 + wid] = wdone ? 1u : 0u;
    }
#undef AT_STAGE
    {
        LAS bf16_t* stg = (LAS bf16_t*)(lds + AT_OST) + wid * 2048;
#pragma unroll
        for (int r = 0; r < 16; ++r) { const int orow = crow(r, hi); stg[orow * 64 + r32] = f2bf(o0[r]); stg[orow * 64 + 32 + r32] = f2bf(o1[r]); }
        asm volatile("s_waitcnt lgkmcnt(0)" ::: "memory");
        bf16_t* Ow = PM + (rowbase + q0 + wid * 32) * PMP + 2560 + h * 64; size_t opitch = PMP;
        if (dmy) { Ow = dmy + (rowbase + q0 + wid * 32) * 512 + h * 64; opitch = 512; }
#pragma unroll
        for (int i = 0; i < 4; ++i) { const int row = i * 8 + (lane >> 3), c8 = lane & 7; const u32x4 v = *(const LAS u32x4*)(stg + row * 64 + c8 * 8); *(u32x4*)(Ow + (size_t)row * opitch + c8 * 8) = v; }
        asm volatile("s_waitcnt lgkmcnt(0)" ::: "memory");
    }
}

DI void sgu_unit(LAS unsigned char* lds, bf16_t* PM, const bf16_t* WsT, const float* lng, const float* lnb, const float* sb, int chunk, int g, bf16_t* dmy) {
    int tid_ = threadIdx.x; asm volatile("" : "+v"(tid_)); const int tid = tid_, lane = tid & 63, r32 = lane & 31, hi = lane >> 5, wid = __builtin_amdgcn_readfirstlane(tid >> 6);
    LAS bf16_t* vT = (LAS bf16_t*)lds;
    LAS float* dstf = (LAS float*)(lds + 36864);
    const size_t tok0 = (size_t)chunk * 128;
    const int tb = wid & 3, chh = wid >> 2;
    const bf16_t* Ap = WsT + (size_t)g * 16384 + (32 * tb + r32) * 128 + 8 * hi;
    bf16x8 Afr[8];
#pragma unroll
    for (int ks = 0; ks < 8; ++ks) { if (ks < 2 * (tb + 1)) Afr[ks] = *(const bf16x8*)(Ap + 16 * ks); else Afr[ks] = (bf16x8){0, 0, 0, 0, 0, 0, 0, 0}; }
    const int er = tid >> 4, ep = tid & 15;
    bf16_t* ubase = PM + (tok0 + er) * PMP + 1536 + 128 * g + 8 * ep;
    u32x4 uraw[4];
#pragma unroll
    for (int i = 0; i < 4; ++i) uraw[i] = *(const u32x4*)(ubase + (size_t)(32 * i) * PMP);
    u32x4 vr[16];
#pragma unroll
    for (int i = 0; i < 16; ++i) vr[i] = *(const u32x4*)(PM + (tok0 + 16 * wid + i) * PMP + 2048 + 8 * lane);
    const int s_ = tid >> 2, qd = tid & 3;
    u32x4 gr[4];
#pragma unroll
    for (int i = 0; i < 4; ++i) gr[i] = *(const u32x4*)(PM + (tok0 + s_) * PMP + 2048 + 128 * g + 32 * qd + 8 * i);
    __syncthreads();
    LAS f32x2* red = (LAS f32x2*)(lds + 36864) + wid * (16 * 65);
#pragma unroll
    for (int i = 0; i < 16; ++i) { float f[8]; unpack8(vr[i], f); float sm = 0.f, sq = 0.f;
#pragma unroll
        for (int e = 0; e < 8; ++e) { sm += f[e]; sq += f[e] * f[e]; }
        red[i * 65 + lane] = (f32x2){sm, sq}; }
    f32x2 mr;
    {
        __builtin_amdgcn_fence(__ATOMIC_RELEASE, "wavefront"); __builtin_amdgcn_wave_barrier(); __builtin_amdgcn_fence(__ATOMIC_ACQUIRE, "wavefront");
        f32x2 ac = {0.f, 0.f}; const LAS f32x2* rp = red + (lane >> 2) * 65 + (lane & 3) * 16;
#pragma unroll
        for (int j = 0; j < 16; ++j) ac += rp[j];
        ac.x += __shfl_xor(ac.x, 1); ac.y += __shfl_xor(ac.y, 1); ac.x += __shfl_xor(ac.x, 2); ac.y += __shfl_xor(ac.y, 2);
        const float mean = ac.x * (1.0f / 512.0f), var = fmaxf(ac.y * (1.0f / 512.0f) - mean * mean, 0.f);
        mr = (f32x2){mean, 1.0f / sqrtf(var + EPS)};
    }
    {
#pragma unroll
        for (int i = 0; i < 4; ++i) { const int c0 = 32 * qd + 8 * i; float f[8]; unpack8(gr[i], f);
            const f32x4 g0 = *(const f32x4*)(lng + 128 * g + c0), g1 = *(const f32x4*)(lng + 128 * g + c0 + 4), b0 = *(const f32x4*)(lnb + 128 * g + c0), b1 = *(const f32x4*)(lnb + 128 * g + c0 + 4);
#pragma unroll
            for (int e = 0; e < 4; ++e) { vT[(c0 + e) * 136 + s_] = f2bf((f[e] - mr.x) * mr.y * g0[e] + b0[e]); vT[(c0 + 4 + e) * 136 + s_] = f2bf((f[4 + e] - mr.x) * mr.y * g1[e] + b1[e]); } }
    }
    __syncthreads();
    f32x16 a0, a1;
#pragma unroll
    for (int r = 0; r < 16; ++r) { a0[r] = 0.f; a1[r] = 0.f; }
    const LAS bf16_t* Bp = vT + (64 * chh + r32) * 136 + 8 * hi;
#pragma unroll
    for (int ks = 0; ks < 8; ++ks) { if (ks < 2 * (tb + 1)) {
        const bf16x8 B0 = *(const LAS bf16x8*)(Bp + 16 * ks), B1 = *(const LAS bf16x8*)(Bp + 32 * 136 + 16 * ks);
        a0 = __builtin_amdgcn_mfma_f32_32x32x16_bf16(Afr[ks], B0, a0, 0, 0, 0); a1 = __builtin_amdgcn_mfma_f32_32x32x16_bf16(Afr[ks], B1, a1, 0, 0, 0); } }
#pragma unroll
    for (int r = 0; r < 16; ++r) { const int t = 32 * tb + crow(r, hi); const float bias = sb[g * 128 + t];
        dstf[t * 132 + 64 * chh + r32] = a0[r] + bias; dstf[t * 132 + 64 * chh + 32 + r32] = a1[r] + bias; }
    __syncthreads();
#pragma unroll
    for (int i = 0; i < 4; ++i) { const int t = er + 32 * i; float u[8], o[8]; unpack8(uraw[i], u);
        const f32x4 m0 = *(const LAS f32x4*)(dstf + t * 132 + 8 * ep), m1 = *(const LAS f32x4*)(dstf + t * 132 + 8 * ep + 4);
#pragma unroll
        for (int e = 0; e < 4; ++e) { o[e] = u[e] * m0[e]; o[4 + e] = u[4 + e] * m1[e]; }
        bf16_t* op = dmy ? dmy + (tok0 + t) * 512 + 128 * g + 8 * ep : ubase + (size_t)(32 * i) * PMP;
        *(u32x4*)op = pack8(o); }
}

DI void conv_unit(bf16_t* PM, const float* cw, const float* cb, int tile, bf16_t* dmy) {
    int tid_ = threadIdx.x; asm volatile("" : "+v"(tid_)); const int tid = tid_, lane = tid & 63, wid = tid >> 6; const int tok_s = tile * 64 + wid * 8, c0 = lane * 8;
    float w0[8], w1[8], w2[8], bb[8], um2[8], um1[8];
#pragma unroll
    for (int e = 0; e < 8; ++e) { w0[e] = cw[c0 + e]; w1[e] = cw[512 + c0 + e]; w2[e] = cw[1024 + c0 + e]; bb[e] = cb[c0 + e]; um2[e] = 0.f; um1[e] = 0.f; }
    const int pos0 = tok_s % SEQ_;
    if (pos0 >= 2) unpack8(*(const u32x4*)(PM + (size_t)(tok_s - 2) * PMP + 512 + c0), um2);
    if (pos0 >= 1) unpack8(*(const u32x4*)(PM + (size_t)(tok_s - 1) * PMP + 512 + c0), um1);
    u32x4 ru[8], rg[8];
#pragma unroll
    for (int t = 0; t < 8; ++t) { const bf16_t* row = PM + (size_t)(tok_s + t) * PMP; ru[t] = __builtin_nontemporal_load((const u32x4*)(row + 512 + c0)); rg[t] = __builtin_nontemporal_load((const u32x4*)(row + c0)); }
#pragma unroll
    for (int t = 0; t < 8; ++t) { bf16_t* row = PM + (size_t)(tok_s + t) * PMP; float uu[8], g[8], o[8];
        unpack8(ru[t], uu); unpack8(rg[t], g);
#pragma unroll
        for (int e = 0; e < 8; ++e) { const float y = bb[e] + w0[e] * um2[e] + w1[e] * um1[e] + w2[e] * uu[e]; o[e] = g[e] * y; um2[e] = um1[e]; um1[e] = uu[e]; }
        *(u32x4*)(dmy ? dmy + (size_t)(tok_s + t) * 512 + c0 : row + c0) = pack8(o); }
}

DI void mixer_phase(const Params& p, LAS unsigned char* lds, int l, bf16_t* dmy) {
    bf16_t* PM = (bf16_t*)(p.ws + WS_BIG);
    const int G = gridDim.x;
    const bool rev = ((blockIdx.x >> 3) & 1) != 0;
    for (int st = 0; st < 4; ++st) {
        const int which = rev ? 3 - st : st;
        if (which == 0) { for (int u = blockIdx.x; u < 512; u += G) attn_unit(lds, PM, p.qg + l * 64, p.kg + l * 64, u >> 8, (u >> 5) & 7, 31 - (u & 31), dmy); }
        else if (which == 1) { for (int u = blockIdx.x; u < 512; u += G) sgu_unit(lds, PM, (const bf16_t*)(p.ws + (size_t)l * WS_WL + W_SG), p.ln_g + l * 512, p.ln_b + l * 512, p.sgu_b + l * 512, u >> 2, u & 3, dmy); }
        else if (which == 2) { for (int u = blockIdx.x; u < 256; u += G) conv_unit(PM, p.conv_w + l * 1536, p.conv_b + l * 512, u, dmy); }
        else if (!dmy) {
            __syncthreads(); if (l == 0) convert_items(p, lds, I_MAIN, 2 * I_IN - I_MAIN + I_REST); else convert_items(p, lds, 2 * I_IN + I_REST, I_REST);
            asm volatile("s_waitcnt lgkmcnt(0)" ::: "memory"); __syncthreads(); }
    }
}


#define XB_TMO      128
#define XB_XCNT(j)  (256  + 64 * (j))
#define XB_XSUB(j)  (1280 + 64 * (j))
#define XB_XGEN(j)  (2304 + 64 * (j))
#define XB_TOP      3328
#define XB_TOPGEN   3392
#define XCD_BAR_WORDS 3456
#define XB_SPIN_CAP (1u << 22)
DI unsigned xb_ld(unsigned* p)              { return __hip_atomic_load(p, __ATOMIC_RELAXED, __HIP_MEMORY_SCOPE_AGENT); }
DI unsigned xb_add(unsigned* p, unsigned v) { return __hip_atomic_fetch_add(p, v, __ATOMIC_RELAXED, __HIP_MEMORY_SCOPE_AGENT); }
DI unsigned xb_xcc_id() { return (unsigned)__builtin_amdgcn_s_getreg((3 << 11) | 20) & 0xFu; }
#define XB_SPIN(cond, bar) do { unsigned _sp = 0; while (cond) { __builtin_amdgcn_s_sleep(1); \
    if ((++_sp & 255u) == 0u) { if (xb_ld(&(bar)[XB_TMO])) break; if (_sp > XB_SPIN_CAP) { atomicAdd(&(bar)[XB_TMO], 1u); break; } } } } while (0)
struct XcdBarrier { unsigned* bar; unsigned x; volatile LAS unsigned* st; };
DI XcdBarrier xcd_barrier_post(unsigned* bar, volatile LAS unsigned* st) {
    XcdBarrier b; b.bar = bar; b.x = xb_xcc_id(); b.st = st;
    if (threadIdx.x == 0) (void)xb_add(&bar[XB_XCNT(b.x)], 1u);
    return b;
}
DI void xcd_barrier_complete(unsigned* bar, unsigned x, unsigned& nloc, unsigned& nx) {
    const unsigned G = gridDim.x * gridDim.y * gridDim.z;
    unsigned sum, cnt, mine, sp = 0u;
    for (;;) {
        sum = 0u; cnt = 0u; mine = 0u;
#pragma unroll
        for (unsigned j = 0; j < 16; ++j) { const unsigned c = xb_ld(&bar[XB_XCNT(j)]); sum += c; cnt += (c > 0u) ? 1u : 0u; mine = (j == x) ? c : mine; }
        if (sum == G) break;
        __builtin_amdgcn_s_sleep(1);
        if ((++sp & 255u) == 0u) { if (xb_ld(&bar[XB_TMO])) break; if (sp > XB_SPIN_CAP) { atomicAdd(&bar[XB_TMO], 1u); break; } }
    }
    nloc = mine > 0u ? mine : 1u; nx = cnt > 0u ? cnt : 1u;
}
DI void xcd_barrier(const XcdBarrier& b) {
    asm volatile("s_waitcnt vmcnt(0)" ::: "memory");
    __syncthreads();
    if (threadIdx.x == 0) {
        unsigned* bar = b.bar;
        __builtin_amdgcn_s_waitcnt(0);
        unsigned nloc = b.st[0], nx = b.st[1];
        if (nloc == 0u) { xcd_barrier_complete(bar, b.x, nloc, nx); b.st[0] = nloc; b.st[1] = nx; }
        const unsigned old = xb_add(&bar[XB_XSUB(b.x)], 1u);
        const unsigned gen = old / nloc;
        if (old + 1u == (gen + 1u) * nloc) {
            __builtin_amdgcn_fence(__ATOMIC_RELEASE, "agent");
            asm volatile("s_waitcnt vmcnt(0)" ::: "memory");
            const unsigned og = xb_add(&bar[XB_TOP], 1u);
            const unsigned tg = og / nx;
            if (og + 1u == (tg + 1u) * nx) xb_add(&bar[XB_TOPGEN], 1u);
            else XB_SPIN(xb_ld(&bar[XB_TOPGEN]) == tg, bar);
            __builtin_amdgcn_fence(__ATOMIC_ACQUIRE, "agent");
            xb_add(&bar[XB_XGEN(b.x)], 1u);
            asm volatile("s_waitcnt vmcnt(0)" ::: "memory");
        } else {
            XB_SPIN(xb_ld(&bar[XB_XGEN(b.x)]) == gen, bar);
            __builtin_amdgcn_fence(__ATOMIC_ACQUIRE, "agent");
            asm volatile("s_waitcnt vmcnt(0)" ::: "memory");
        }
    }
    __syncthreads();
}

DI void panel_barrier(unsigned* cnt, unsigned target, bool same_xcd) {
    asm volatile("s_waitcnt vmcnt(0)" ::: "memory");
    __syncthreads();
    if (threadIdx.x == 0) {
        if (!same_xcd) { __builtin_amdgcn_fence(__ATOMIC_RELEASE, "agent"); asm volatile("s_waitcnt vmcnt(0)" ::: "memory"); }
        (void)xb_add(cnt, 1u);
        unsigned sp = 0;
        while (xb_ld(cnt) < target) { __builtin_amdgcn_s_sleep(1); if (++sp > (1u << 24)) break; }
        __builtin_amdgcn_fence(__ATOMIC_ACQUIRE, "agent"); asm volatile("s_waitcnt vmcnt(0)" ::: "memory");
    }
    __syncthreads();
}

__global__ void __launch_bounds__(512, 2) fwd_kernel(Params p) {
    extern __shared__ __attribute__((aligned(16))) unsigned char lds_raw[];
    LAS unsigned char* lds = (LAS unsigned char*)lds_raw;
    cg::grid_group grid = cg::this_grid();
    const int G = gridDim.x, c = blockIdx.x;
    bf16_t* PM = (bf16_t*)(p.ws + WS_BIG); bf16_t* XB = (bf16_t*)(p.ws + WS_XB); float* part = (float*)(p.ws + WS_PART); float* rsv = (float*)(p.ws + WS_RSV);
    volatile LAS unsigned* MISC = (volatile LAS unsigned*)(lds + 134144);
    if (threadIdx.x < 2) MISC[threadIdx.x] = 0u;
    __syncthreads();
    const XcdBarrier xbar = xcd_barrier_post((unsigned*)(p.ws + WS_BAR), MISC);
    unsigned* pcnt = (unsigned*)(p.ws + WS_BAR + 16384) + 64 * (8 * (c % 8) + ((c >> 3) & 7)); int npanel = 0;
    unsigned* xccs = (unsigned*)(p.ws + WS_XCC); bool same_xcd = false;
    if (threadIdx.x == 0) __hip_atomic_store(xccs + c, xbar.x + 1u, __ATOMIC_RELAXED, __HIP_MEMORY_SCOPE_AGENT);
    if (p.ph_hi > 1000) grid.sync();
    for (int ph = p.ph_lo; ph < p.ph_hi; ++ph) {
#ifndef PHMASK
#define PHMASK 127
#endif
#ifndef DUP_PH
#define DUP_PH -1
#endif
        const int reps = (ph == DUP_PH) ? 2 : 1;
        for (int rep = 0; rep < reps; ++rep) {
        bf16_t* dmy = (reps == 2 && rep == 0) ? (bf16_t*)(p.ws + WS_DMY) : nullptr;
        if (ph == 0) {
            if (G == 256) {
                phase0(p, lds, 0, 0);
                xcd_barrier(xbar);
                { const int c0 = c & 63; unsigned ok = 1u;
#pragma unroll
                    for (int j = 0; j < 4; ++j) ok &= (xb_ld(xccs + c0 + 64 * j) == xbar.x + 1u) ? 1u : 0u;
                    same_xcd = ok != 0u; }
                phase0(p, lds, 2, (8 * (c % 8) + ((c >> 3) & 7)) * 256 + (c >> 6) * 64);
            } else phase0(p, lds, 1, 0);
        }
        else {
            const int l = (ph - 1) / 6, k = (ph - 1) % 6; const unsigned char* wl = p.ws + (size_t)l * WS_WL;
            if (k == 0 && (PHMASK & 2)) {
                pg8::SchedPlain S; S.o.init(T_, NMAIN, G, c); S.A = (const char*)XB; S.B = (const char*)(wl + W_IN); S.lda2 = 2048; S.ldb2 = 2048; S.nt = 16; S.astride = 256 * 2048;
                pg8::EpiMain E{PM, part, rsv}; pg8::gemm_phase(lds, S, E);
            } else if (k == 1 && (PHMASK & 4)) {
                mixer_phase(p, lds, l, dmy);
            } else if (k == 2 && (PHMASK & 8)) {
                pg8::SchedBO S; S.o.init(T_, D_, G, c); S.XB = (const char*)XB; S.PM = (const char*)PM; S.WgT = (const char*)(wl + W_IN) + (size_t)NMAIN * 2048; S.WboT = (const char*)(wl + W_BO);
                pg8::EpiBO E{PM, rsv, p.b_gate + l * 3072}; pg8::gemm_phase(lds, S, E);
            } else if ((k == 3 || k == 5) && (PHMASK & 16)) {
                pg8::SchedPlain S; S.o.init(T_, D_, G, c);
                if (k == 3) { S.A = (const char*)(PM + COL_MG); S.B = (const char*)(wl + W_O); S.lda2 = PMP * 2; S.ldb2 = 2048; S.nt = 16; S.astride = (size_t)256 * PMP * 2; }
                else { S.A = (const char*)PM; S.B = (const char*)(wl + W_DN); S.lda2 = DFF * 2; S.ldb2 = DFF * 2; S.nt = DFF / 64; S.astride = (size_t)256 * PMP * 2; }
                pg8::EpiRes E{(k == 5 && l == 1) ? p.out : nullptr, XB, part}; pg8::gemm_phase(lds, S, E);
            } else if (k == 4 && (PHMASK & 32)) {
                if ((NGU / 256 * 64 - c + G - 1) / G < (NGU / 256 * 64 + G - 1) / G) { for (int i = 0; i < 3; ++i) __builtin_amdgcn_s_sleep(127); }
                pg8::SchedPlain S; S.o.init(T_, NGU, G, c); S.A = (const char*)XB; S.B = (const char*)(wl + W_GU); S.lda2 = 2048; S.ldb2 = 2048; S.nt = 16; S.astride = 256 * 2048;
                pg8::EpiGU E{PM, part}; pg8::gemm_phase(lds, S, E);
            }
        }
        if (rep + 1 < reps) __syncthreads();
        }
        if (ph + 1 < p.ph_hi) {
            const int kk = (ph == 0) ? -1 : (ph - 1) % 6;
            if (G == 256 && (kk >= 2 || ph == 0)) { ++npanel; panel_barrier(pcnt, 4u * (unsigned)npanel, same_xcd); }
            else { xcd_barrier(xbar);
                if (ph == 0 && G == 256) { const int c0 = c & 63; unsigned ok = 1u;
#pragma unroll
                    for (int j = 0; j < 4; ++j) ok &= (xb_ld(xccs + c0 + 64 * j) == xbar.x + 1u) ? 1u : 0u;
                    same_xcd = ok != 0u; } }
        }
    }
}

#ifndef N_LAUNCH_SPLIT
#define N_LAUNCH_SPLIT 0
#endif
extern "C" void kernel_launch(void* const* d_in, const int* in_sizes, int n_in, void* d_out, int out_size, void* d_ws, size_t ws_size, hipStream_t stream) {
    static int grid = 0;
    if (grid == 0) {
        if (n_in != 17 || out_size != T_ * D_ || ws_size < WS_END + 262144) { fprintf(stderr, "kernel_launch: unexpected shapes (n_in %d out %d ws %zu)\n", n_in, out_size, ws_size); grid = -1; return; }
        int dev = 0, cus = 0, per_cu = 0;
        hipGetDevice(&dev); hipDeviceGetAttribute(&cus, hipDeviceAttributeMultiprocessorCount, dev);
        hipFuncSetAttribute((const void*)fwd_kernel, hipFuncAttributeMaxDynamicSharedMemorySize, LDS_BYTES);
        hipOccupancyMaxActiveBlocksPerMultiprocessor(&per_cu, (const void*)fwd_kernel, 512, LDS_BYTES);
        if (per_cu < 1) { fprintf(stderr, "kernel_launch: occupancy query says %d blocks/CU\n", per_cu); per_cu = 1; }
        (void)hipGetLastError();
        grid = cus * 1;
    }
    if (grid < 0) return;
    Params p{};
    p.x = (const float*)d_in[0]; p.mix_g = (const float*)d_in[1]; p.w_in = (const float*)d_in[2]; p.b_gate = (const float*)d_in[3]; p.conv_w = (const float*)d_in[4]; p.conv_b = (const float*)d_in[5];
    p.ln_g = (const float*)d_in[6]; p.ln_b = (const float*)d_in[7]; p.sgu_w = (const float*)d_in[8]; p.sgu_b = (const float*)d_in[9]; p.qg = (const float*)d_in[10]; p.kg = (const float*)d_in[11];
    p.w_bo = (const float*)d_in[12]; p.w_o = (const float*)d_in[13]; p.ffn_g = (const float*)d_in[14]; p.w_gu = (const float*)d_in[15]; p.w_dn = (const float*)d_in[16];
    p.out = (float*)d_out; p.ws = (unsigned char*)d_ws;
#if N_LAUNCH_SPLIT
    for (int ph = 0; ph < 13; ++ph) { p.ph_lo = ph; p.ph_hi = ph + 1; hipLaunchKernelGGL(fwd_kernel, dim3(grid), dim3(512), LDS_BYTES, stream, p); }
#else
    p.ph_lo = 0; p.ph_hi = 13;
    (void)hipMemsetAsync((char*)d_ws + WS_BAR, 0, 32768, stream);
    void* args[] = {&p};
    hipError_t e = hipLaunchCooperativeKernel((const void*)fwd_kernel, dim3(grid), dim3(512), args, LDS_BYTES, stream);
    if (e != hipSuccess) fprintf(stderr, "cooperative launch failed: %s (grid %d)\n", hipGetErrorString(e), grid);
#endif
}
```
